# Optimizing an MI355X kernel written in HIP

```python
import jax
import jax.numpy as jnp
from jax import lax
import numpy as np

D_MODEL = 1024
BATCH = 8
SEQ = 2048
DEPTH = 4

ATT_HEADS = 8
ATT_KV_HEADS = 2
ATT_HEAD_DIM = 64
ATT_GROUP = ATT_HEADS // ATT_KV_HEADS
ATT_WIDTH = ATT_HEADS * ATT_HEAD_DIM
KV_WIDTH = ATT_KV_HEADS * ATT_HEAD_DIM
WINDOW = 128
ATT_BLOCK = 128
ROPE_THETA = 500000.0
ROPE_DIM = ATT_HEAD_DIM // 4

HG_HEADS = 4
HG_HEAD_DIM = 128
HG_WIDTH = HG_HEADS * HG_HEAD_DIM
HG_CHUNK = 64

MIX_WIDTH = ATT_WIDTH + HG_WIDTH
IN_WIDTH = ATT_WIDTH + 2 * KV_WIDTH + 5 * HG_WIDTH

N_EXPERTS = 32
TOP_K = 4
D_FF = 1024
SWIGLU_ALPHA = 1.702
SWIGLU_LIMIT = 7.0
MOE_BLOCK = 256

N_MOD = 6
EPS = 1e-6
NEG_INF = -1e30
LB_FLOOR = 1e-30

kernel_name = "hymba_swa_hgrn2_moe_adaln_encoder"


def rms_norm(x, gain):
    xf = x.astype(jnp.float32)
    y = xf * lax.rsqrt(jnp.mean(xf * xf, axis=-1, keepdims=True) + EPS)
    return (y * gain.astype(jnp.float32)).astype(x.dtype)


def partial_rope(x, positions):
    half = ROPE_DIM // 2
    inv_freq = ROPE_THETA ** (-(jnp.arange(half, dtype=jnp.float32) * 2.0 / ROPE_DIM))
    ang = positions.astype(jnp.float32)[..., None] * inv_freq
    cos = jnp.cos(ang)[:, :, None, :]
    sin = jnp.sin(ang)[:, :, None, :]
    xr = x[..., :ROPE_DIM].astype(jnp.float32)
    x1, x2 = xr[..., :half], xr[..., half:]
    rot = jnp.concatenate([x1 * cos - x2 * sin, x2 * cos + x1 * sin], axis=-1).astype(x.dtype)
    return jnp.concatenate([rot, x[..., ROPE_DIM:]], axis=-1)


def window_attention(q, k, v, sink):
    B, S = q.shape[0], q.shape[1]
    nb = S // ATT_BLOCK
    qb = q.reshape(B, nb, ATT_BLOCK, ATT_KV_HEADS, ATT_GROUP, ATT_HEAD_DIM)
    pad = ((0, 0), (ATT_BLOCK, ATT_BLOCK), (0, 0), (0, 0))
    kp = jnp.pad(k, pad).reshape(B, nb + 2, ATT_BLOCK, ATT_KV_HEADS, ATT_HEAD_DIM)
    vp = jnp.pad(v, pad).reshape(B, nb + 2, ATT_BLOCK, ATT_KV_HEADS, ATT_HEAD_DIM)
    kb = jnp.concatenate([kp[:, :-2], kp[:, 1:-1], kp[:, 2:]], axis=2)
    vb = jnp.concatenate([vp[:, :-2], vp[:, 1:-1], vp[:, 2:]], axis=2)
    s = jnp.einsum("bnqhgd,bnshd->bnhgqs", qb, kb,
                   preferred_element_type=jnp.float32) * (ATT_HEAD_DIM ** -0.5)
    blk = jnp.arange(nb)[:, None, None]
    qpos = blk * ATT_BLOCK + jnp.arange(ATT_BLOCK)[None, :, None]
    kpos = (blk - 1) * ATT_BLOCK + jnp.arange(3 * ATT_BLOCK)[None, None, :]
    valid = (jnp.abs(qpos - kpos) <= WINDOW) & (kpos >= 0) & (kpos < S)
    s = jnp.where(valid[None, :, None, None], s, NEG_INF)
    sink_col = jnp.broadcast_to(
        sink.astype(jnp.float32).reshape(1, 1, ATT_KV_HEADS, ATT_GROUP, 1, 1), s.shape[:-1] + (1,))
    p = jax.nn.softmax(jnp.concatenate([s, sink_col], axis=-1), axis=-1)[..., :-1]
    o = jnp.einsum("bnhgqs,bnshd->bnqhgd", p.astype(v.dtype), vb)
    return o.reshape(B, S, ATT_WIDTH)


def chunked_gated_scan(q, k, v, log_f):
    N, S, H, DK = q.shape
    DV = v.shape[-1]
    nc = S // HG_CHUNK

    def to_chunks(t):
        return t.reshape(N, nc, HG_CHUNK, H, t.shape[-1]).transpose(1, 0, 3, 2, 4)

    lower_tri = jnp.tril(jnp.ones((HG_CHUNK, HG_CHUNK), dtype=bool))

    def step(state, xs):
        qc, kc, vc, gc = xs
        b = jnp.cumsum(gc, axis=2)
        inter = jnp.einsum("nhcd,nhde->nhce", qc * jnp.exp(b), state)
        rel = jnp.where(lower_tri[:, :, None], b[:, :, :, None, :] - b[:, :, None, :, :], NEG_INF)
        scores = jnp.einsum("nhtd,nhsd,nhtsd->nhts", qc, kc, jnp.exp(rel))
        intra = jnp.einsum("nhts,nhse->nhte", scores, vc)
        b_last = b[:, :, -1:, :]
        new_state = (jnp.exp(b_last[:, :, 0, :])[..., None] * state
                     + jnp.einsum("nhsd,nhse->nhde", kc * jnp.exp(b_last - b), vc))
        return new_state, inter + intra

    state0 = jnp.zeros((N, H, DK, DV), jnp.float32)
    _, out = lax.scan(step, state0, (to_chunks(q), to_chunks(k), to_chunks(v), to_chunks(log_f)))
    return out.transpose(1, 0, 3, 2, 4).reshape(N, S, H, DV)


def hgrn2_bidirectional(q, f_fwd, f_bwd, i, lb_fwd, lb_bwd):
    B, S = q.shape[0], q.shape[1]

    def heads(t):
        return t.astype(jnp.float32).reshape(B, S, HG_HEADS, HG_HEAD_DIM)

    def forget(f, lb):
        f = heads(f)
        lb = lb.astype(jnp.float32).reshape(HG_HEADS, HG_HEAD_DIM)
        log_lb = jnp.log(jnp.maximum(lb, LB_FLOOR))
        log_f = jnp.logaddexp(log_lb, jnp.log1p(-lb) + jax.nn.log_sigmoid(f))
        key = (1.0 - lb) * jax.nn.sigmoid(-f)
        return log_f, key

    qh = jax.nn.silu(heads(q))
    vh = heads(i)
    lf_f, k_f = forget(f_fwd, lb_fwd)
    lf_b, k_b = forget(f_bwd, lb_bwd)
    rev = lambda t: jnp.flip(t, axis=1)
    out = chunked_gated_scan(jnp.concatenate([qh, rev(qh)], axis=0),
                             jnp.concatenate([k_f, rev(k_b)], axis=0),
                             jnp.concatenate([vh, rev(vh)], axis=0),
                             jnp.concatenate([lf_f, rev(lf_b)], axis=0))
    return out[:B] + rev(out[B:])


def hybrid_mixer(h, positions, w_in, sink, attn_gain, lb_fwd, lb_bwd, hg_gain, w_out):
    B, S = h.shape[0], h.shape[1]
    proj = jnp.einsum("bsd,de->bse", h, w_in)
    cuts = np.cumsum([ATT_WIDTH, KV_WIDTH, KV_WIDTH, HG_WIDTH, HG_WIDTH, HG_WIDTH, HG_WIDTH])
    q_a, k_a, v_a, q_h, f_fw, f_bw, i_h, g_h = jnp.split(proj, [int(t) for t in cuts], axis=-1)
    q_a = partial_rope(q_a.reshape(B, S, ATT_HEADS, ATT_HEAD_DIM), positions)
    k_a = partial_rope(k_a.reshape(B, S, ATT_KV_HEADS, ATT_HEAD_DIM), positions)
    v_a = v_a.reshape(B, S, ATT_KV_HEADS, ATT_HEAD_DIM)
    a = rms_norm(window_attention(q_a, k_a, v_a, sink), attn_gain)
    o = hgrn2_bidirectional(q_h, f_fw, f_bw, i_h, lb_fwd, lb_bwd)
    o = rms_norm(o, hg_gain) * jax.nn.silu(g_h.astype(jnp.float32).reshape(B, S, HG_HEADS, HG_HEAD_DIM))
    o = o.reshape(B, S, HG_WIDTH).astype(h.dtype)
    mixed = jnp.concatenate([a.astype(h.dtype), o], axis=-1)
    return jnp.einsum("bse,ed->bsd", mixed, w_out)


def moe_ffn(h, w_router, b_router, w_gu, b_gu, w_down, b_down):
    B, S, D = h.shape
    T = B * S
    xt = h.reshape(T, D)
    logits = (xt @ w_router).astype(jnp.float32) + b_router.astype(jnp.float32)
    top_val, top_idx = lax.top_k(logits, TOP_K)
    gates = jax.nn.softmax(top_val, axis=-1)
    TK = T * TOP_K
    flat_e = top_idx.reshape(TK).astype(jnp.int32)
    flat_tok = jnp.arange(TK, dtype=jnp.int32) // TOP_K
    flat_g = gates.reshape(TK)
    counts = jnp.zeros((N_EXPERTS,), jnp.int32).at[flat_e].add(1)
    padded = (counts + MOE_BLOCK - 1) // MOE_BLOCK * MOE_BLOCK
    start = jnp.cumsum(counts) - counts
    pend = jnp.cumsum(padded)
    pstart = pend - padded
    order = jnp.argsort(flat_e)
    se = flat_e[order]
    dest = pstart[se] + jnp.arange(TK, dtype=jnp.int32) - start[se]
    cap = TK + N_EXPERTS * MOE_BLOCK
    nblk = cap // MOE_BLOCK
    buf_tok = jnp.zeros((cap,), jnp.int32).at[dest].set(flat_tok[order])
    buf_g = jnp.zeros((cap,), jnp.float32).at[dest].set(flat_g[order])
    blk_expert = jnp.clip(jnp.searchsorted(pend, jnp.arange(nblk, dtype=jnp.int32) * MOE_BLOCK,
                                           side="right"), 0, N_EXPERTS - 1).astype(jnp.int32)
    xs = xt[buf_tok].reshape(nblk, MOE_BLOCK, D)

    def expert_block(args):
        xb, e = args
        hu = xb @ w_gu[e] + b_gu[e]
        glu = jnp.minimum(hu[:, :D_FF], SWIGLU_LIMIT)
        lin = jnp.clip(hu[:, D_FF:], -SWIGLU_LIMIT, SWIGLU_LIMIT)
        act = glu * jax.nn.sigmoid(SWIGLU_ALPHA * glu) * (lin + 1.0)
        return act @ w_down[e] + b_down[e]

    ys = lax.map(expert_block, (xs, blk_expert)).reshape(cap, D)
    out = jnp.zeros((T, D), ys.dtype).at[buf_tok].add(ys * buf_g[:, None].astype(ys.dtype))
    return out.reshape(B, S, D).astype(h.dtype)


def setup_inputs(seed: int = 0) -> dict:
    key = jax.random.key(seed)
    ks = jax.random.split(key, 20)
    f32 = jnp.float32

    def nrm(k, shape, scale):
        return scale * jax.random.normal(k, shape, f32)

    def gain(k, shape):
        return 1.0 + 0.02 * jax.random.normal(k, shape, f32)

    return {
        "x": jax.random.normal(ks[0], (BATCH, SEQ, D_MODEL), f32),
        "c": jax.random.normal(ks[1], (BATCH, D_MODEL), f32),
        "positions": jnp.broadcast_to(jnp.arange(SEQ, dtype=jnp.int32), (BATCH, SEQ)),
        "w_ada": nrm(ks[2], (DEPTH, D_MODEL, N_MOD * D_MODEL), 0.5 * D_MODEL ** -0.5),
        "b_ada": nrm(ks[3], (DEPTH, N_MOD * D_MODEL), 0.02),
        "norm1": gain(ks[4], (DEPTH, D_MODEL)),
        "w_in": nrm(ks[5], (DEPTH, D_MODEL, IN_WIDTH), D_MODEL ** -0.5),
        "attn_sink": nrm(ks[6], (DEPTH, ATT_HEADS), 0.5),
        "attn_norm": gain(ks[7], (DEPTH, ATT_WIDTH)),
        "hg_lb_logits": nrm(ks[8], (DEPTH, 2, HG_WIDTH), 0.5),
        "hg_norm": gain(ks[9], (DEPTH, HG_HEAD_DIM)),
        "w_out": nrm(ks[10], (DEPTH, MIX_WIDTH, D_MODEL), MIX_WIDTH ** -0.5),
        "norm2": gain(ks[11], (DEPTH, D_MODEL)),
        "w_router": nrm(ks[12], (DEPTH, D_MODEL, N_EXPERTS), D_MODEL ** -0.5),
        "b_router": nrm(ks[13], (DEPTH, N_EXPERTS), 0.01),
        "w_gu": nrm(ks[14], (DEPTH, N_EXPERTS, D_MODEL, 2 * D_FF), D_MODEL ** -0.5),
        "b_gu": nrm(ks[15], (DEPTH, N_EXPERTS, 2 * D_FF), 0.02),
        "w_down": nrm(ks[16], (DEPTH, N_EXPERTS, D_FF, D_MODEL), D_FF ** -0.5),
        "b_down": nrm(ks[17], (DEPTH, N_EXPERTS, D_MODEL), 0.02),
        "final_norm": gain(ks[18], (D_MODEL,)),
    }


def reference(x, c, positions, w_ada, b_ada, norm1, w_in, attn_sink, attn_norm, hg_lb_logits,
              hg_norm, w_out, norm2, w_router, b_router, w_gu, b_gu, w_down, b_down, final_norm):
    cond = jax.nn.silu(c)
    lb_p = jax.nn.softmax(hg_lb_logits.astype(jnp.float32), axis=0)
    lower = jnp.cumsum(lb_p, axis=0) - lb_p[0]
    for l in range(DEPTH):
        mod = cond @ w_ada[l] + b_ada[l]
        sh1, sc1, g1, sh2, sc2, g2 = jnp.split(mod[:, None, :], N_MOD, axis=-1)
        h = rms_norm(x, norm1[l]) * (1.0 + sc1) + sh1
        x = x + g1 * hybrid_mixer(h, positions, w_in[l], attn_sink[l], attn_norm[l],
                                  lower[l, 0], lower[l, 1], hg_norm[l], w_out[l])
        h = rms_norm(x, norm2[l]) * (1.0 + sc2) + sh2
        x = x + g2 * moe_ffn(h, w_router[l], b_router[l], w_gu[l], b_gu[l], w_down[l], b_down[l])
    return rms_norm(x, final_norm)
```

```cpp
#include <hip/hip_runtime.h>
#include <stdint.h>

namespace {
constexpr int D = 1024, NB = 8, SEQ = 2048, T = NB * SEQ, DEPTH = 4;
constexpr int INW = 3328, NE = 32, TOPK = 4, DFF = 1024, NP = T * TOPK;
constexpr int C_QA = 0, C_KA = 512, C_VA = 640, C_QH = 768, C_FF = 1280, C_FB = 1792, C_IH = 2304, C_GH = 2816;
constexpr float EPS = 1e-6f;
#define LAS __attribute__((address_space(3)))
typedef unsigned short bf16_t;
typedef short bf16x8 __attribute__((ext_vector_type(8)));
typedef float f32x4 __attribute__((ext_vector_type(4)));
typedef unsigned u32x2 __attribute__((ext_vector_type(2)));
typedef unsigned u32x4 __attribute__((ext_vector_type(4)));
typedef int i32x8 __attribute__((ext_vector_type(8)));
typedef short s16x16a __attribute__((ext_vector_type(16), aligned(16)));
typedef float f32x2_t __attribute__((ext_vector_type(2)));
typedef __bf16 bf16x2_t __attribute__((ext_vector_type(2)));
__device__ __forceinline__ unsigned cvt_pk_bf16(float lo, float hi) { const bf16x2_t r = __builtin_convertvector((f32x2_t){lo, hi}, bf16x2_t); return __builtin_bit_cast(unsigned, r); }
__device__ __forceinline__ unsigned cvt_pk4_fp8(float a, float b, float c, float d) { int w = 0; w = __builtin_amdgcn_cvt_pk_fp8_f32(a, b, w, false); w = __builtin_amdgcn_cvt_pk_fp8_f32(c, d, w, true); return (unsigned)w; }
constexpr float MX_SCALE = 1.f;
constexpr float W8_SCALE = 64.f, ACT8_SCALE = 4.f, H28_SCALE = 8.f, Y8_SCALE = 16.f;
__device__ __forceinline__ bf16_t f2bf(float f) { unsigned u = __float_as_uint(f); u += 0x7FFFu + ((u >> 16) & 1u); return (bf16_t)(u >> 16); }
__device__ __forceinline__ float bf2f(bf16_t b) { return __uint_as_float(((unsigned)b) << 16); }
__device__ __forceinline__ int tid_hidden() { int t = threadIdx.x; asm volatile("" : "+v"(t)); return t; }
#define GAS __attribute__((address_space(1)))
__device__ __forceinline__ float fexp(float x) { return __builtin_amdgcn_exp2f(x * 1.4426950408889634f); }
__device__ __forceinline__ float flog(float x) { return __builtin_amdgcn_logf(x) * 0.6931471805599453f; }
__device__ __forceinline__ float kf(float x) { asm volatile("" : "+s"(x)); return x; }
__device__ __forceinline__ float shx(float v, int m) { int ln; asm volatile("v_mbcnt_lo_u32_b32 %0, -1, 0\n\tv_mbcnt_hi_u32_b32 %0, -1, %0" : "=v"(ln)); return __builtin_bit_cast(float, __builtin_amdgcn_ds_bpermute((ln ^ m) << 2, __builtin_bit_cast(int, v))); }
__device__ __forceinline__ GAS unsigned char* ptr_hidden(GAS unsigned char* p) { asm volatile("" : "+s"(p)); return p; }
__device__ __forceinline__ int sgpr_hidden(int v) { asm volatile("" : "+s"(v)); return v; }
__device__ __forceinline__ LAS unsigned char* lds_hidden(LAS unsigned char* p) { asm volatile("" : "+s"(p)); return p; }
__device__ __forceinline__ unsigned xb_ld(unsigned* p)              { unsigned GAS* g = (unsigned GAS*)p; asm volatile("" : "+s"(g)); return __hip_atomic_load(g, __ATOMIC_RELAXED, __HIP_MEMORY_SCOPE_AGENT); }
__device__ __forceinline__ unsigned xb_add(unsigned* p, unsigned v) { unsigned GAS* g = (unsigned GAS*)p; asm volatile("" : "+s"(g)); return __hip_atomic_fetch_add(g, v, __ATOMIC_RELAXED, __HIP_MEMORY_SCOPE_AGENT); }
#define PROBE 0
namespace g8 {
constexpr int BM = 256, BK = 64, HALF = 128, HTB = HALF * BK * 2, STAGE_BYTES = 8 * HTB, KD = 1024, NKT = KD / BK;
constexpr int TAB_OFF = STAGE_BYTES;
constexpr int LDS_TOTAL = 147456;
__device__ __forceinline__ int lds_byte(int r, int c) { const int st = (r >> 4) * 2 + (c >> 5), rr = r & 15, cc = c & 31, ob = rr * 64 + cc * 2; return st * 1024 + (ob ^ (((ob >> 9) & 1) << 5)); }
__device__ __forceinline__ void stage_rc(int b, int& R, int& C) { const int st = b / 1024, sb = b % 1024, swz = sb ^ (((sb >> 9) & 1) << 5); R = (st >> 1) * 16 + swz / 64; C = (st & 1) * 32 + (swz % 64) / 2; }
__host__ __device__ __forceinline__ int perm32(int rho) { const int n = rho >> 4, i = rho & 15; return 8 * (i >> 2) + 4 * n + (i & 3); }

struct Unit { int e, rt, pn, cnt, rowbase; };

constexpr int PRE_OFF = TAB_OFF + 2048;
constexpr int EPI_OFF = PRE_OFF + 512;
constexpr int ULIST_OFF = EPI_OFF + 4096;
template <bool GATHER_, int NTN, bool FP8_, bool WAITS_ = false, bool REV_ = false>
struct MoeSrc {
    static constexpr bool GATHER = GATHER_, FP8 = FP8_, WAITS = WAITS_;
    unsigned* done;
    __device__ __forceinline__ int tile_of(int i) const { return (lo + rk + i * nw) / NTN; }
    __device__ __forceinline__ void publish(int i) const { if (threadIdx.x == 0) (void)xb_add(done + tile_of(i), 1u); }
    __device__ __forceinline__ void wait_tile(int i) const {
        if (threadIdx.x == 0) { unsigned* w = done + tile_of(i); unsigned sp = 0u;
            while (xb_ld(w) < 8u) { __builtin_amdgcn_s_sleep(1); if (++sp > (1u << 16)) break; } }
    }
    static constexpr int RB = FP8_ ? KD : KD * 2;
    const bf16_t* A; const int* ltok; const bf16_t* Bt; LAS const int* tb;
    int nw, rk, lo, hi;
    __device__ __forceinline__ void init(LAS unsigned char* lds, const bf16_t* A_, const int* ltok_, const bf16_t* Bt_, const int* cnt, int G, int c) {
        A = A_; ltok = ltok_; Bt = Bt_;
        LAS int* t = (LAS int*)(lds + PRE_OFF); tb = t;
        __syncthreads();
        const int tidi = tid_hidden();
        if (tidi == 0) { int run = 0, ro = 0; for (int e = 0; e < NE; ++e) { const int ce = cnt[e]; t[e] = run; t[33 + e] = ro; t[66 + e] = ce; run += ((ce + 255) >> 8) * NTN; ro += ((ce + 255) >> 8) << 8;   } t[32] = run; t[65] = ro; }
        __syncthreads();
        const int U = __builtin_amdgcn_readfirstlane(t[32]), xg = c & 7;
        nw = (G + 7 - xg) >> 3; rk = REV_ ? nw - 1 - (c >> 3) : (c >> 3);
        lo = (int)(((long)xg * U) >> 3); hi = (int)(((long)(xg + 1) * U) >> 3);
        if (tidi < 16) { Unit u; const bool ok = next_slow<false>(tidi, u); LAS int* r = t + (ULIST_OFF - PRE_OFF) / 4 + tidi * 8;
            r[0] = ok ? u.e : -1; r[1] = u.rt; r[2] = u.pn; r[3] = u.cnt; r[4] = u.rowbase; }
        __syncthreads();
    }
    template <bool UNI>
    __device__ __forceinline__ bool next_slow(int i, Unit& u) const {
        const int g = lo + rk + i * nw; if (g >= hi) return false;
        int e = 0;
#pragma unroll
        for (int st = 16; st > 0; st >>= 1) { const int v = UNI ? __builtin_amdgcn_readfirstlane(tb[e + st]) : tb[e + st]; if (v <= g) e += st; }
        const int p = tb[e], cn = tb[66 + e], ro = tb[33 + e];
        const int loc = g - (UNI ? __builtin_amdgcn_readfirstlane(p) : p);
        u.e = e; u.rt = loc / NTN; u.pn = loc % NTN; u.cnt = UNI ? __builtin_amdgcn_readfirstlane(cn) : cn; u.rowbase = UNI ? __builtin_amdgcn_readfirstlane(ro) : ro;
        return true;
    }
    __device__ __forceinline__ bool next(int i, Unit& u) const {
        if (i < 16) {
            LAS const int* r = tb + (ULIST_OFF - PRE_OFF) / 4 + i * 8;
            const int e = __builtin_amdgcn_readfirstlane(r[0]);
            if (e < 0) return false;
            u.e = e; u.rt = __builtin_amdgcn_readfirstlane(r[1]); u.pn = __builtin_amdgcn_readfirstlane(r[2]); u.cnt = __builtin_amdgcn_readfirstlane(r[3]); u.rowbase = __builtin_amdgcn_readfirstlane(r[4]);
            return true;
        }
        return next_slow<true>(i, u);
    }
    __device__ __forceinline__ const char* bptr(const Unit& u) const { return (const char*)Bt + ((size_t)u.e * NTN * BM + (size_t)u.pn * BM) * RB; }
};

typedef short s16x16 __attribute__((ext_vector_type(16)));
__device__ __forceinline__ i32x8 frag8(bf16x8 lo, bf16x8 hi) { return __builtin_bit_cast(i32x8, __builtin_shufflevector(lo, hi, 0, 1, 2, 3, 4, 5, 6, 7, 8, 9, 10, 11, 12, 13, 14, 15)); }
template <class Src>
__device__ __forceinline__ void tab_fill(const Src& S, const Unit& u, int tid, int wid, LAS unsigned char* lds, int par) {
    if (Src::GATHER && wid < 4) {
        int rr = u.rt * BM + tid; rr = rr < u.cnt ? rr : u.cnt - 1;
        __builtin_amdgcn_global_load_lds((const unsigned*)(S.ltok + (size_t)u.e * T + rr), (LAS unsigned*)(lds + TAB_OFF + par * 1024 + wid * 256), 4, 0, 0);
    }
}

template <class Epi, class Src>
__device__ __forceinline__ void gemm_phase(LAS unsigned char* lds, const Src S, const Epi E) {
    const int tid = tid_hidden(), wid = __builtin_amdgcn_readfirstlane(tid >> 6), lane = tid & 63, wr = wid >> 2, wc = wid & 3, fr = lane & 15, fq = lane >> 4;
    int R0, C0; stage_rc(tid * 16, R0, C0);
    constexpr int RB = Src::RB, NKTR = RB / 128;
    const unsigned vo0 = (unsigned)(R0 * RB + C0 * 2);
    const unsigned tabA = (unsigned)R0 * 4u, colB = (unsigned)C0 * 2u;
    const size_t kstep = (size_t)(BK * 2);
    const size_t hstep = (size_t)HALF * RB;
    const unsigned ldsw = (unsigned)wid * 1024u;
    const int aoff = lds_byte(wr * 64 + fr, fq * 8);
    const int boff = lds_byte(wc * 32 + fr, fq * 8);
#define G8_SA(b, h) (((b) * 2 + (h)) * HTB)
#define G8_SB(b, h) ((4 + (b) * 2 + (h)) * HTB)
#define G8_GLDS(gp, bufoff, i) __builtin_amdgcn_global_load_lds((const unsigned*)(gp), (LAS unsigned*)(lds + (bufoff) + ldsw + (i) * 8192), 16, 0, 0)
#define G8_STAGE_U(bufoff, gbase) do { const char* _g = (const char*)(gbase); const char* _g1 = _g + (size_t)(64 * RB); asm volatile("" : "+s"(_g), "+s"(_g1));   \
        G8_GLDS(_g + vo0, bufoff, 0); G8_GLDS(_g1 + vo0, bufoff, 1); } while (0)
    unsigned tv0 = 0u, tv1 = 0u;
#define G8_TABRD(par, h) do { if constexpr (Src::GATHER) { LAS const int* _t = (LAS const int*)(lds + TAB_OFF + (par) * 1024 + (h) * 512 + tabA); tv0 = (unsigned)_t[0]; tv1 = (unsigned)_t[64]; } } while (0)
#define G8_STAGE_G(bufoff, kb) do { const char* _gb = Ab + (kb); G8_GLDS(_gb + (tv0 * (unsigned)RB + colB), bufoff, 0); G8_GLDS(_gb + (tv1 * (unsigned)RB + colB), bufoff, 1); } while (0)
#define G8_STAGE_A(bufoff, up, par, h, kb) do { if constexpr (Src::GATHER) G8_STAGE_G(bufoff, kb); else G8_STAGE_U(bufoff, (up) + (h) * hstep + (kb)); } while (0)
#define G8_LDA(dst, b, h) do { if constexpr (Src::FP8) { _Pragma("unroll") for (int m = 0; m < 4; ++m) dst##8[m] = frag8(*(const LAS bf16x8*)(lds + G8_SA(b, h) + aoff + m * 2048), *(const LAS bf16x8*)(lds + G8_SA(b, h) + aoff + m * 2048 + 1024)); } \
        else { _Pragma("unroll") for (int m = 0; m < 4; ++m) _Pragma("unroll") for (int k = 0; k < 2; ++k) dst[m][k] = *(const LAS bf16x8*)(lds + G8_SA(b, h) + aoff + m * 2048 + k * 1024); } } while (0)
#define G8_LDB(dst, b, h) do { if constexpr (Src::FP8) { _Pragma("unroll") for (int n = 0; n < 2; ++n) dst##8[n] = frag8(*(const LAS bf16x8*)(lds + G8_SB(b, h) + boff + n * 2048), *(const LAS bf16x8*)(lds + G8_SB(b, h) + boff + n * 2048 + 1024)); } \
        else { _Pragma("unroll") for (int n = 0; n < 2; ++n) _Pragma("unroll") for (int k = 0; k < 2; ++k) dst[n][k] = *(const LAS bf16x8*)(lds + G8_SB(b, h) + boff + n * 2048 + k * 1024); } } while (0)
#define G8_MMA(ai, bj, At, Bt) do { __builtin_amdgcn_s_setprio(1); _Pragma("unroll") for (int m = 0; m < 4; ++m) _Pragma("unroll") for (int n = 0; n < 2; ++n) { \
        if constexpr (Src::FP8) acc[ai][bj][m][n] = __builtin_amdgcn_mfma_scale_f32_16x16x128_f8f6f4(Bt##8[n], At##8[m], acc[ai][bj][m][n], 0, 0, 0, mxs, 0, mxs); \
        else { _Pragma("unroll") for (int k = 0; k < 2; ++k) acc[ai][bj][m][n] = __builtin_amdgcn_mfma_f32_16x16x32_bf16(Bt[n][k], At[m][k], acc[ai][bj][m][n], 0, 0, 0); } } \
        __builtin_amdgcn_s_setprio(0); } while (0)
#define G8_WAIT_V(n) asm volatile("s_waitcnt vmcnt(" #n ")" ::: "memory")
#define G8_WAIT_L(n) asm volatile("s_waitcnt lgkmcnt(" #n ")" ::: "memory")
#define G8_BAR __builtin_amdgcn_s_barrier()
#define G8_SCHED __builtin_amdgcn_sched_barrier(0)
    Unit cur, nxt; int ui = 0;
    if (!S.next(0, cur)) return;
    if constexpr (Src::WAITS) { S.wait_tile(0); __syncthreads(); }
    f32x4 acc[2][2][4][2];
#pragma unroll
    for (int a = 0; a < 2; ++a)
#pragma unroll
        for (int b = 0; b < 2; ++b)
#pragma unroll
            for (int m = 0; m < 4; ++m)
#pragma unroll
                for (int n = 0; n < 2; ++n) acc[a][b][m][n] = (f32x4){0.f, 0.f, 0.f, 0.f};
    bf16x8 At[4][2], B0[2][2], B1[2][2];
    i32x8 At8[4], B08[2], B18[2];
    int mxs = 0x7f7f7f7f; asm volatile("" : "+v"(mxs));
    const char* Ab = (const char*)S.A;
    const char* cB = S.bptr(cur);
    const char* cA = Ab + (size_t)(cur.rowbase + cur.rt * BM) * RB;
    int par = 0;
    if (Src::GATHER) { tab_fill(S, cur, tid, wid, lds, 0); G8_WAIT_V(0); __syncthreads(); }
    G8_STAGE_U(G8_SB(0, 0), cB); G8_TABRD(0, 0); G8_STAGE_A(G8_SA(0, 0), cA, 0, 0, 0); G8_STAGE_U(G8_SB(0, 1), cB + hstep); G8_TABRD(0, 1); G8_STAGE_A(G8_SA(0, 1), cA, 0, 1, 0);
    if (wr == 1) G8_BAR;
    G8_WAIT_V(4); G8_BAR;
    G8_STAGE_U(G8_SB(1, 0), cB + kstep); G8_TABRD(0, 0); G8_STAGE_A(G8_SA(1, 0), cA, 0, 0, kstep); G8_STAGE_U(G8_SB(1, 1), cB + hstep + kstep);
    G8_WAIT_V(6); G8_BAR;
    for (;;) {
        const bool has_next = S.next(ui + 1, nxt);
        if constexpr (Src::WAITS) { if (has_next) S.wait_tile(ui + 1); }
        if constexpr (Epi::PUBLISH) { if (ui >= 2) S.publish(ui - 2); }
        const char* nB = has_next ? S.bptr(nxt) : cB;
        const char* nA = has_next ? Ab + (size_t)(nxt.rowbase + nxt.rt * BM) * RB : cA;
#define G8_ITER(UP1, PAR1, KB1, UP2, PAR2, KB2, b2, b3) do { \
              \
            G8_TABRD(PAR1, 1); G8_SCHED; G8_LDB(B0, 0, 0); G8_SCHED; G8_LDA(At, 0, 0); G8_STAGE_A(G8_SA(1, 1), UP1, PAR1, 1, KB1); \
            G8_WAIT_L(8); G8_BAR; G8_WAIT_L(0); G8_MMA(0, 0, At, B0); G8_BAR; G8_SCHED; \
              \
            G8_LDB(B1, 0, 1); G8_STAGE_U(G8_SB(0, 0), b2); \
            G8_BAR; G8_WAIT_L(0); G8_MMA(0, 1, At, B1); G8_BAR; \
              \
            G8_TABRD(PAR2, 0); G8_SCHED; G8_LDA(At, 0, 1); G8_STAGE_A(G8_SA(0, 0), UP2, PAR2, 0, KB2); \
            G8_BAR; G8_WAIT_L(0); G8_MMA(1, 0, At, B0); G8_BAR; G8_SCHED; \
              \
            G8_STAGE_U(G8_SB(0, 1), (b2) + hstep); \
            G8_WAIT_V(6); G8_BAR; G8_MMA(1, 1, At, B1); G8_BAR; \
              \
            G8_TABRD(PAR2, 1); G8_SCHED; G8_LDB(B0, 1, 0); G8_SCHED; G8_LDA(At, 1, 0); G8_STAGE_A(G8_SA(0, 1), UP2, PAR2, 1, KB2); \
            G8_WAIT_L(8); G8_BAR; G8_WAIT_L(0); G8_MMA(0, 0, At, B0); G8_BAR; G8_SCHED; \
              \
            G8_LDB(B1, 1, 1); G8_STAGE_U(G8_SB(1, 0), b3); \
            G8_BAR; G8_WAIT_L(0); G8_MMA(0, 1, At, B1); G8_BAR; \
              \
            G8_TABRD(PAR2, 0); G8_SCHED; G8_LDA(At, 1, 1); G8_STAGE_A(G8_SA(1, 0), UP2, PAR2, 0, (KB2) + kstep); \
            G8_BAR; G8_WAIT_L(0); G8_MMA(1, 0, At, B0); G8_BAR; G8_SCHED; \
              \
            G8_STAGE_U(G8_SB(1, 1), (b3) + hstep); \
            G8_WAIT_V(6); G8_BAR; G8_MMA(1, 1, At, B1); G8_BAR; } while (0)
        { const int tp = tid_hidden(); E.prefetch(cur, lds, par, tp, __builtin_amdgcn_readfirstlane(tp >> 6)); }
        if (Src::GATHER && has_next) { const int tp = tid_hidden(); tab_fill(S, nxt, tp, __builtin_amdgcn_readfirstlane(tp >> 6), lds, par ^ 1); }
        for (int t = 0; t < NKTR - 2; t += 2) {
            const size_t k1 = (size_t)(t + 1) * kstep, k2 = (size_t)(t + 2) * kstep;
            const char* b2 = cB + k2; const char* b3 = b2 + kstep;
            G8_ITER(cA, par, k1, cA, par, k2, b2, b3);
        }
        {
            const int par2 = has_next ? (par ^ 1) : par;
            const char* b3 = nB + kstep;
            G8_ITER(cA, par, (size_t)(NKTR - 1) * kstep, nA, par2, (size_t)0, nB, b3);
        }
#undef G8_ITER
        { int tz = threadIdx.x; asm volatile("" : "+v"(tz));
          const int wid2 = __builtin_amdgcn_readfirstlane(tz >> 6), lane2 = tz & 63;
          E(acc, cur, wid2 >> 2, wid2 & 3, lane2 & 15, lane2 >> 4, lds, par); }
        if (!has_next) break;
#pragma unroll
        for (int a = 0; a < 2; ++a)
#pragma unroll
            for (int b = 0; b < 2; ++b)
#pragma unroll
                for (int m = 0; m < 4; ++m)
#pragma unroll
                    for (int n = 0; n < 2; ++n) acc[a][b][m][n] = (f32x4){0.f, 0.f, 0.f, 0.f};
        cur = nxt; cB = nB; cA = nA; ++ui; par ^= 1;
    }
    G8_WAIT_V(0);
    if (wr == 0) G8_BAR;
    G8_BAR;
    if constexpr (Epi::PUBLISH) { if (ui >= 1) S.publish(ui - 1); S.publish(ui); }
#undef G8_SA
#undef G8_SB
#undef G8_GLDS
#undef G8_STAGE_U
#undef G8_STAGE_G
#undef G8_TABRD
#undef G8_STAGE_A
#undef G8_LDA
#undef G8_LDB
#undef G8_MMA
#undef G8_WAIT_V
#undef G8_WAIT_L
#undef G8_BAR
#undef G8_SCHED
}

struct EpiGU {
    static constexpr bool PUBLISH = true;
    unsigned char* act; const float* b_gu;
    __device__ __forceinline__ void prefetch(const Unit& u, LAS unsigned char* lds, int par, int tid, int wid) const {
        if (wid >= 4) { const int i = tid - 256;
            __builtin_amdgcn_global_load_lds((const unsigned*)(b_gu + (size_t)u.e * 2048 + u.pn * 128 + (i & 127) + (i >> 7) * 1024), (LAS unsigned*)(lds + EPI_OFF + par * 2048 + (wid - 4) * 256), 4, 0, 0); }
    }
    __device__ __forceinline__ void operator()(const f32x4 (&acc)[2][2][4][2], const Unit& u, int wr, int wc, int fr, int fq, LAS unsigned char* lds, int par) const {
        LAS const float* tb = (LAS const float*)(lds + EPI_OFF + par * 2048);
        const int colu = wc * 32 + 8 * fq, col = u.pn * 128 + colu;
        const f32x4 bg0 = *(LAS const f32x4*)(tb + colu), bg1 = *(LAS const f32x4*)(tb + colu + 4), bl0 = *(LAS const f32x4*)(tb + 128 + colu), bl1 = *(LAS const f32x4*)(tb + 128 + colu + 4);
        const float sc = kf(1.f / (W8_SCALE * H28_SCALE * MX_SCALE)), lim = kf(7.f), ke = kf(-1.702f * 1.4426950408889634f), one = kf(1.f), as = kf(ACT8_SCALE);
        const f32x2_t sc2 = (f32x2_t){sc, sc}, ke2 = (f32x2_t){ke, ke}, one2 = (f32x2_t){one, one}, as2 = (f32x2_t){as, as};
#pragma unroll
        for (int ai = 0; ai < 2; ++ai)
#pragma unroll
            for (int m = 0; m < 4; ++m) {
                const int r = u.rt * BM + ai * HALF + wr * 64 + m * 16 + fr;
                f32x2_t o[4];
#pragma unroll
                for (int n = 0; n < 2; ++n)
#pragma unroll
                    for (int h = 0; h < 2; ++h) {
                        const f32x4 bgv = n ? bg1 : bg0, blv = n ? bl1 : bl0;
                        f32x2_t glu = (f32x2_t){acc[ai][0][m][n][2 * h], acc[ai][0][m][n][2 * h + 1]} * sc2 + (f32x2_t){bgv[2 * h], bgv[2 * h + 1]};
                        f32x2_t lin = (f32x2_t){acc[ai][1][m][n][2 * h], acc[ai][1][m][n][2 * h + 1]} * sc2 + (f32x2_t){blv[2 * h], blv[2 * h + 1]};
                        glu.x = fminf(glu.x, lim); glu.y = fminf(glu.y, lim);
                        lin.x = __builtin_amdgcn_fmed3f(lin.x, -lim, lim); lin.y = __builtin_amdgcn_fmed3f(lin.y, -lim, lim);
                        const f32x2_t t = glu * ke2;
                        const f32x2_t d = (f32x2_t){__builtin_amdgcn_exp2f(t.x), __builtin_amdgcn_exp2f(t.y)} + one2;
                        const f32x2_t rc = (f32x2_t){__builtin_amdgcn_rcpf(d.x), __builtin_amdgcn_rcpf(d.y)};
                        o[n * 2 + h] = (glu * rc) * (lin * as2 + as2);
                    }
                const int ro = u.rowbase + r;
                u32x2 w; w.x = cvt_pk4_fp8(o[0].x, o[0].y, o[1].x, o[1].y); w.y = cvt_pk4_fp8(o[2].x, o[2].y, o[3].x, o[3].y);
                __hip_atomic_store((unsigned long long GAS*)(act + (size_t)ro * DFF + col), ((unsigned long long)w.y << 32) | w.x, __ATOMIC_RELAXED, __HIP_MEMORY_SCOPE_AGENT);
            }
    }
};
struct EpiDown {
    static constexpr bool PUBLISH = false;
    unsigned char* y; const float* b_down; const float* lgate;
    __device__ __forceinline__ void prefetch(const Unit& u, LAS unsigned char* lds, int par, int tid, int wid) const {
        if (wid >= 4) __builtin_amdgcn_global_load_lds((const unsigned*)(b_down + (size_t)u.e * D + u.pn * BM + (tid - 256)), (LAS unsigned*)(lds + EPI_OFF + par * 2048 + (wid - 4) * 256), 4, 0, 0);
        else { int rr = u.rt * BM + tid; rr = rr < u.cnt ? rr : u.cnt - 1;
            __builtin_amdgcn_global_load_lds((const unsigned*)(lgate + (size_t)u.e * T + rr), (LAS unsigned*)(lds + EPI_OFF + par * 2048 + 1024 + wid * 256), 4, 0, 0); }
    }
    __device__ __forceinline__ void operator()(const f32x4 (&acc)[2][2][4][2], const Unit& u, int wr, int wc, int fr, int fq, LAS unsigned char* lds, int par) const {
        LAS const float* tb = (LAS const float*)(lds + EPI_OFF + par * 2048);
#pragma unroll
        for (int ai = 0; ai < 2; ++ai)
#pragma unroll
            for (int m = 0; m < 4; ++m) {
                const int ru = ai * HALF + wr * 64 + m * 16 + fr, r = u.rt * BM + ru;
                const int ro = u.rowbase + r;
                const float g = tb[256 + ru] * Y8_SCALE;
#pragma unroll
                for (int bj = 0; bj < 2; ++bj) {
                    const int colu = bj * HALF + wc * 32 + 8 * fq;
                    const f32x4 bd0 = *(LAS const f32x4*)(tb + colu), bd1 = *(LAS const f32x4*)(tb + colu + 4);
                    const f32x4 v0 = (acc[ai][bj][m][0] * (1.f / (W8_SCALE * ACT8_SCALE * MX_SCALE)) + bd0) * g;
                    const f32x4 v1 = (acc[ai][bj][m][1] * (1.f / (W8_SCALE * ACT8_SCALE * MX_SCALE)) + bd1) * g;
                    u32x2 w; w.x = cvt_pk4_fp8(v0[0], v0[1], v0[2], v0[3]); w.y = cvt_pk4_fp8(v1[0], v1[1], v1[2], v1[3]);
                    *(u32x2*)(y + (size_t)ro * D + u.pn * BM + colu) = w;
                }
            }
    }
};

struct DenseSrc {
    static constexpr bool GATHER = false, FP8 = false, WAITS = false;
    static constexpr int RB = KD * 2;
    const bf16_t* A; const int* ltok; const bf16_t* Bt; int nM, nN, nwg, G, c, pn0;
    __device__ __forceinline__ void init(const bf16_t* A_, const bf16_t* Bt_, int pn0_, int nN_, int G_, int c_) { A = A_; ltok = nullptr; Bt = Bt_; nM = T / BM; nN = nN_; pn0 = pn0_; nwg = nM * nN; G = G_; c = c_; }
    __device__ __forceinline__ bool next(int i, Unit& u) const {
        const int L = i * G + c; if (L >= nwg) return false;
        int wgid = L; { const int q = nwg / 8, r = nwg % 8, xcd = wgid % 8, off = wgid / 8; wgid = (xcd < r ? xcd * (q + 1) : r * (q + 1) + (xcd - r) * q) + off; }
        const int nig = 8 * nN, gid = wgid / nig, fm = gid * 8, gsz = (nM - fm) < 8 ? (nM - fm) : 8;
        u.rt = fm + ((wgid % nig) % gsz); u.pn = pn0 + (wgid % nig) / gsz; u.e = 0; u.cnt = T; u.rowbase = 0; return true;
    }
    __device__ __forceinline__ const char* bptr(const Unit& u) const { return (const char*)Bt + (size_t)u.pn * BM * KD * 2; }
};
struct EpiOutRes {
    static constexpr bool PUBLISH = false;
    bf16_t* X; const float* gate;
    __device__ __forceinline__ void prefetch(const Unit&, LAS unsigned char*, int, int, int) const {}
    __device__ __forceinline__ void operator()(const f32x4 (&acc)[2][2][4][2], const Unit& u, int wr, int wc, int fr, int fq, LAS unsigned char*, int) const {
        const int b = (u.rt * BM) / SEQ;
        const int col0 = u.pn * BM + wc * 32 + 8 * fq;
        f32x4 g[2][2];
#pragma unroll
        for (int bj = 0; bj < 2; ++bj)
#pragma unroll
            for (int n = 0; n < 2; ++n) g[bj][n] = *(const f32x4*)(gate + (size_t)b * 6 * D + col0 + bj * HALF + n * 4);
        u32x4 xn[2];
        { const bf16_t* pi = X + (size_t)(u.rt * BM + wr * 64 + fr) * D + col0;
#pragma unroll
          for (int bj = 0; bj < 2; ++bj) xn[bj] = *(const u32x4*)(pi + bj * HALF); }
#pragma unroll
        for (int g8i = 0; g8i < 8; ++g8i) {
            const int ai = g8i >> 2, m = g8i & 3;
            const size_t po = (size_t)(u.rt * BM + ai * HALF + wr * 64 + m * 16 + fr) * D + col0;
            u32x4 xv[2];
#pragma unroll
            for (int bj = 0; bj < 2; ++bj) xv[bj] = xn[bj];
            if (g8i < 7) { const int ai2 = (g8i + 1) >> 2, m2 = (g8i + 1) & 3; const bf16_t* pi = X + (size_t)(u.rt * BM + ai2 * HALF + wr * 64 + m2 * 16 + fr) * D + col0;
#pragma unroll
                for (int bj = 0; bj < 2; ++bj) xn[bj] = *(const u32x4*)(pi + bj * HALF); }
            bf16_t* p = X + po;
#pragma unroll
            for (int bj = 0; bj < 2; ++bj) {
                const u32x4 xw = xv[bj];
                const f32x4 x0 = (f32x4){__uint_as_float(xw.x << 16), __uint_as_float(xw.x & 0xffff0000u), __uint_as_float(xw.y << 16), __uint_as_float(xw.y & 0xffff0000u)};
                const f32x4 x1 = (f32x4){__uint_as_float(xw.z << 16), __uint_as_float(xw.z & 0xffff0000u), __uint_as_float(xw.w << 16), __uint_as_float(xw.w & 0xffff0000u)};
                const f32x4 r0 = x0 + g[bj][0] * acc[ai][bj][m][0], r1 = x1 + g[bj][1] * acc[ai][bj][m][1];
                u32x4 w; w.x = cvt_pk_bf16(r0[0], r0[1]); w.y = cvt_pk_bf16(r0[2], r0[3]); w.z = cvt_pk_bf16(r1[0], r1[1]); w.w = cvt_pk_bf16(r1[2], r1[3]);
                *(u32x4*)(p + bj * HALF) = w;
            }
            asm volatile("" ::: "memory");
        }
    }
};
#define EP_FENCE() asm volatile("" ::: "memory")
struct EpiProj {
    static constexpr bool PUBLISH = false;
    bf16_t* QA; bf16_t* KA; bf16_t* VTA; bf16_t* QH; bf16_t* LF; bf16_t* VTH; bf16_t* GS;
    const float* rope;
    const float* lbl;
    __device__ __forceinline__ void store_vt(bf16_t* base, unsigned voff0, const f32x4 (&acc)[2][2][4][2], int bj0, int bj1) const {
#pragma unroll
        for (int ai = 0; ai < 2; ++ai)
#pragma unroll
            for (int m = 0; m < 4; ++m) {
#pragma unroll
                for (int bj = 0; bj < 2; ++bj) {
                    if (bj < bj0 || bj > bj1) continue;
#pragma unroll
                    for (int n = 0; n < 2; ++n)
#pragma unroll
                        for (int j = 0; j < 4; ++j) {
                            const unsigned off = voff0 + (unsigned)((ai * HALF + m * 16) * 2 + ((bj - bj0) * HALF + n * 4 + j) * SEQ * 2);
                            *(bf16_t*)((char*)base + off) = f2bf(acc[ai][bj][m][n][j]);
                        }
                }
                EP_FENCE();
            }
    }
    __device__ __forceinline__ void prefetch(const Unit&, LAS unsigned char*, int, int, int) const {}
    __device__ __forceinline__ void operator()(const f32x4 (&acc)[2][2][4][2], const Unit& u, int wr, int wc, int fr, int fq, LAS unsigned char*, int) const {
        const int pn = u.pn;
        const int row0 = u.rt * BM + wr * 64 + fr;
        if (pn <= 2) {
            if (pn == 2) {
                const int b = row0 / SEQ, sp = row0 % SEQ;
                store_vt(VTA, (unsigned)(((b * 128 + wc * 32 + 8 * fq) * SEQ + sp) * 2), acc, 1, 1);
            }
            bf16_t* dst = (pn == 2) ? KA : QA;
            const int ld = (pn == 2) ? 128 : 512;
            const float scl = (pn == 2) ? 1.f : 0.125f;
#pragma unroll
            for (int bj = 0; bj < 2; ++bj) {
                if (pn == 2 && bj == 1) continue;
                const unsigned off0 = (unsigned)((row0 * ld + (pn == 2 ? 0 : pn * BM) + bj * HALF + wc * 32 + 8 * fq) * 2);
                const bool rot = (wc & 1) == 0;
                f32x4 cn0 = (f32x4){0.f, 0.f, 0.f, 0.f}, cn1 = cn0, sn0 = cn0, sn1 = cn0;
                if (rot) { const float* rp = rope + (size_t)row0 * 16; cn0 = *(const f32x4*)rp; cn1 = *(const f32x4*)(rp + 4); sn0 = *(const f32x4*)(rp + 8); sn1 = *(const f32x4*)(rp + 12); }
#pragma unroll
                for (int g8i = 0; g8i < 8; ++g8i) {
                    const int ai = g8i >> 2, m = g8i & 3;
                    const f32x4 c0 = cn0, c1 = cn1, s0 = sn0, s1 = sn1;
                    if (rot && g8i < 7) { const int row2 = row0 + ((g8i + 1) >> 2) * HALF + ((g8i + 1) & 3) * 16; const float* rp = rope + (size_t)row2 * 16;
                        cn0 = *(const f32x4*)rp; cn1 = *(const f32x4*)(rp + 4); sn0 = *(const f32x4*)(rp + 8); sn1 = *(const f32x4*)(rp + 12); }
                    f32x4 v0 = acc[ai][bj][m][0], v1 = acc[ai][bj][m][1];
                    if (rot) {
#pragma unroll
                        for (int j = 0; j < 4; ++j) {
                            const float o0 = shx(v0[j], 16), o1 = shx(v1[j], 16);
                            v0[j] = (fq == 0) ? (v0[j] * c0[j] - o0 * s0[j]) : ((fq == 1) ? (v0[j] * c0[j] + o0 * s0[j]) : v0[j]);
                            v1[j] = (fq == 0) ? (v1[j] * c1[j] - o1 * s1[j]) : ((fq == 1) ? (v1[j] * c1[j] + o1 * s1[j]) : v1[j]);
                        }
                    }
                    u32x4 w; w.x = cvt_pk_bf16(v0[0] * scl, v0[1] * scl); w.y = cvt_pk_bf16(v0[2] * scl, v0[3] * scl);
                    w.z = cvt_pk_bf16(v1[0] * scl, v1[1] * scl); w.w = cvt_pk_bf16(v1[2] * scl, v1[3] * scl);
                    *(u32x4*)((char*)dst + off0 + (unsigned)((ai * HALF + m * 16) * ld * 2)) = w;
                    EP_FENCE();
                }
            }
        } else if (pn <= 4 || pn >= 11) {
            bf16_t* dst = (pn <= 4) ? QH : GS;
            const unsigned off0 = (unsigned)((row0 * 512 + (pn <= 4 ? (pn - 3) : (pn - 11)) * BM + wc * 32 + 8 * fq) * 2);
            const float nl = kf(-1.4426950408889634f), on = kf(1.f); const f32x2_t nl2 = (f32x2_t){nl, nl}, one2 = (f32x2_t){on, on};
#pragma unroll
            for (int ai = 0; ai < 2; ++ai)
#pragma unroll
                for (int m = 0; m < 4; ++m) {
#pragma unroll
                    for (int bj = 0; bj < 2; ++bj) {
                        const f32x4 v0 = acc[ai][bj][m][0], v1 = acc[ai][bj][m][1];
                        unsigned wq[4];
#pragma unroll
                        for (int q = 0; q < 4; ++q) {
                            const f32x2_t x = q < 2 ? (f32x2_t){v0[2 * q], v0[2 * q + 1]} : (f32x2_t){v1[2 * q - 4], v1[2 * q - 3]};
                            const f32x2_t t = x * nl2;
                            const f32x2_t d = (f32x2_t){__builtin_amdgcn_exp2f(t.x), __builtin_amdgcn_exp2f(t.y)} + one2;
                            const f32x2_t o = x * (f32x2_t){__builtin_amdgcn_rcpf(d.x), __builtin_amdgcn_rcpf(d.y)};
                            wq[q] = cvt_pk_bf16(o.x, o.y);
                        }
                        *(u32x4*)((char*)dst + off0 + (unsigned)(((ai * HALF + m * 16) * 512 + bj * HALF) * 2)) = (u32x4){wq[0], wq[1], wq[2], wq[3]};
                    }
                    EP_FENCE();
                }
        } else if (pn <= 8) {
            const int cb = (pn - 5) * BM + wc * 32 + 8 * fq;
            const unsigned off0 = (unsigned)((row0 * 1024 + cb) * 2);
            const float nl = kf(-1.4426950408889634f), on = kf(1.f), l2 = kf(0.6931471805599453f); const f32x2_t nl2 = (f32x2_t){nl, nl}, one2 = (f32x2_t){on, on}, l22 = (f32x2_t){l2, l2};
            f32x4 lbv[2][2];
#pragma unroll
            for (int bj = 0; bj < 2; ++bj)
#pragma unroll
                for (int n = 0; n < 2; ++n) lbv[bj][n] = *(const f32x4*)(lbl + cb + bj * HALF + n * 4);
#pragma unroll
            for (int bj = 0; bj < 2; ++bj) {
#pragma unroll
                for (int ai = 0; ai < 2; ++ai)
#pragma unroll
                    for (int m = 0; m < 4; ++m) {
                        const f32x4 v0 = acc[ai][bj][m][0], v1 = acc[ai][bj][m][1];
                        unsigned wq[4];
#pragma unroll
                        for (int q = 0; q < 4; ++q) {
                            const f32x2_t x = q < 2 ? (f32x2_t){v0[2 * q], v0[2 * q + 1]} : (f32x2_t){v1[2 * q - 4], v1[2 * q - 3]};
                            const f32x4 lbq = lbv[bj][q >> 1];
                            const f32x2_t lb = (f32x2_t){lbq[2 * (q & 1)], lbq[2 * (q & 1) + 1]};
                            const f32x2_t t = x * nl2;
                            const f32x2_t d = (f32x2_t){__builtin_amdgcn_exp2f(t.x), __builtin_amdgcn_exp2f(t.y)} + one2;
                            const f32x2_t f = (one2 - lb) * (f32x2_t){__builtin_amdgcn_rcpf(d.x), __builtin_amdgcn_rcpf(d.y)} + lb;
                            const f32x2_t o = (f32x2_t){__builtin_amdgcn_logf(fmaxf(f.x, 1e-30f)), __builtin_amdgcn_logf(fmaxf(f.y, 1e-30f))} * l22;
                            wq[q] = cvt_pk_bf16(o.x, o.y);
                        }
                        *(u32x4*)((char*)LF + off0 + (unsigned)(((ai * HALF + m * 16) * 1024 + bj * HALF) * 2)) = (u32x4){wq[0], wq[1], wq[2], wq[3]};
                    }
                EP_FENCE();
            }
        } else {
            const int b = row0 / SEQ, sp = row0 % SEQ;
            store_vt(VTH, (unsigned)(((b * 512 + (pn - 9) * BM + wc * 32 + 8 * fq) * SEQ + sp) * 2), acc, 0, 1);
        }
    }
};
}
namespace att {
constexpr int KROW = 128;
constexpr int VROW = 816;
constexpr int K_BYTES = 400 * KROW;
constexpr int V_OFF = K_BYTES;
constexpr int LDS_BYTES = V_OFF + 64 * VROW;
__device__ __forceinline__ void attn_phase(LAS unsigned char* lds, const bf16_t* __restrict__ QA, const bf16_t* __restrict__ KA, const bf16_t* __restrict__ VTA,
                                           const float* __restrict__ sink_l, bf16_t* __restrict__ AO, float* __restrict__ SSQ, int first, int count, int stride) {
    const int tid = tid_hidden(), wid = __builtin_amdgcn_readfirstlane(tid >> 6), lane = tid & 63, l15 = lane & 15, g4 = lane >> 4;
    for (int it = 0; it < count; ++it) {
        const int item = first + it * stride;
        const int b = item >> 5, qb = (item >> 1) & 15, kvh = item & 1;
        const int kb0 = qb * 128 - 128;
        unsigned z0 = 0u; asm volatile("" : "+v"(z0));
        const u32x4 zz = (u32x4){z0, z0, z0, z0};
        const int hg = wid >> 1, head = kvh * 4 + hg, half = wid & 1;
        const int kc0 = ((g4 ^ (l15 & 7)) * 16);
        const float sk = sink_l[head];
        bf16x8 q0n, q1n;
        { const size_t tokn = (size_t)b * SEQ + qb * 128 + half * 64 + l15;
          q0n = *(const bf16x8*)(QA + tokn * 512 + head * 64 + 8 * g4); q1n = *(const bf16x8*)(QA + tokn * 512 + head * 64 + 32 + 8 * g4); }
        __syncthreads();
#pragma unroll
        for (int i = 0; i < 6; ++i) {
            const int ch = tid + i * 512, kap = ch >> 3, part = ch & 7, kpos = kb0 + kap;
            u32x4 v = zz;
            if (kpos >= 0 && kpos < SEQ) v = *(const u32x4*)(KA + (size_t)(b * SEQ + kpos) * 128 + kvh * 64 + part * 8);
            *(LAS u32x4*)(lds + kap * KROW + ((part ^ (kap & 7)) * 16)) = v;
        }
        if (tid < 128) { const int kap = 384 + (tid >> 3), part = tid & 7; *(LAS u32x4*)(lds + kap * KROW + part * 16) = zz; }
#pragma unroll
        for (int i = 0; i < 6; ++i) {
            const int ch = tid + i * 512, d = ch / 48, kc = ch - d * 48, kpos = kb0 + kc * 8;
            u32x4 v = zz;
            if (kpos >= 0 && kpos < SEQ) v = *(const u32x4*)(VTA + ((size_t)b * 128 + kvh * 64 + d) * SEQ + kpos);
            *(LAS u32x4*)(lds + V_OFF + d * VROW + kc * 16) = v;
        }
        if (tid < 192) { const int d = tid / 3, kc = 48 + (tid - d * 3); *(LAS u32x4*)(lds + V_OFF + d * VROW + kc * 16) = zz; }
        __syncthreads();
#pragma unroll 1
        for (int blk = 0; blk < 4; ++blk) {
            const int t0 = half * 4 + blk, qr0 = t0 * 16, qo = qr0 + l15;
            const size_t tok = (size_t)b * SEQ + qb * 128 + qo;
            const bf16x8 q0 = q0n, q1 = q1n;
            if (blk < 3) { const size_t tokn = tok + 16; q0n = *(const bf16x8*)(QA + tokn * 512 + head * 64 + 8 * g4); q1n = *(const bf16x8*)(QA + tokn * 512 + head * 64 + 32 + 8 * g4); }
            f32x4 sc[18];
            float mx = sk;
#pragma unroll
            for (int i = 0; i < 18; ++i) {
                const LAS unsigned char* kp = lds + ((t0 + i) * 16 + l15) * KROW;
                const bf16x8 k0 = *(const LAS bf16x8*)(kp + kc0), k1 = *(const LAS bf16x8*)(kp + (kc0 ^ 64));
                f32x4 a = (f32x4){0.f, 0.f, 0.f, 0.f};
                a = __builtin_amdgcn_mfma_f32_16x16x32_bf16(k0, q0, a, 0, 0, 0);
                a = __builtin_amdgcn_mfma_f32_16x16x32_bf16(k1, q1, a, 0, 0, 0);
#pragma unroll
                for (int r = 0; r < 4; ++r) {
                    const int kap = (t0 + i) * 16 + 4 * g4 + r, rel = kap - qo, kpos = kb0 + kap;
                    const bool ok = (rel >= 0) && (rel <= 256) && (kpos >= 0) && (kpos < SEQ);
                    a[r] = ok ? a[r] : kf(-1e30f);
                    mx = fmaxf(mx, a[r]);
                }
                sc[i] = a;
            }
            mx = fmaxf(mx, shx(mx, 16)); mx = fmaxf(mx, shx(mx, 32));
            float sum = 0.f;
#pragma unroll
            for (int i = 0; i < 18; ++i)
#pragma unroll
                for (int r = 0; r < 4; ++r) { const float p = fexp(sc[i][r] - mx); sc[i][r] = p; sum += p; }
            sum += shx(sum, 16); sum += shx(sum, 32);
            sum += fexp(sk - mx);
            f32x4 o[4];
#pragma unroll
            for (int dt = 0; dt < 4; ++dt) o[dt] = (f32x4){0.f, 0.f, 0.f, 0.f};
#pragma unroll
            for (int u = 0; u < 9; ++u) {
                u32x4 pw; pw.x = cvt_pk_bf16(sc[2 * u][0], sc[2 * u][1]); pw.y = cvt_pk_bf16(sc[2 * u][2], sc[2 * u][3]);
                pw.z = cvt_pk_bf16(sc[2 * u + 1][0], sc[2 * u + 1][1]); pw.w = cvt_pk_bf16(sc[2 * u + 1][2], sc[2 * u + 1][3]);
                const bf16x8 pf = __builtin_bit_cast(bf16x8, pw);
#pragma unroll
                for (int dt = 0; dt < 4; ++dt) {
                    const LAS unsigned char* vp = lds + V_OFF + (dt * 16 + l15) * VROW + ((t0 + 2 * u) * 16 + 4 * g4) * 2;
                    const u32x2 va = *(const LAS u32x2*)vp, vb = *(const LAS u32x2*)(vp + 32);
                    const bf16x8 vf = __builtin_bit_cast(bf16x8, (u32x4){va.x, va.y, vb.x, vb.y});
                    o[dt] = __builtin_amdgcn_mfma_f32_16x16x32_bf16(vf, pf, o[dt], 0, 0, 0);
                }
            }
            const float inv = 1.f / sum;
            float ss = 0.f;
#pragma unroll
            for (int dt = 0; dt < 4; ++dt) {
                const f32x4 v = o[dt] * inv;
                ss += v[0] * v[0] + v[1] * v[1] + v[2] * v[2] + v[3] * v[3];
                u32x2 w; w.x = cvt_pk_bf16(v[0], v[1]); w.y = cvt_pk_bf16(v[2], v[3]);
                *(u32x2*)(AO + tok * 512 + head * 64 + dt * 16 + 4 * g4) = w;
            }
            ss += shx(ss, 16); ss += shx(ss, 32);
            if (g4 == 0) SSQ[tok * 8 + head] = ss;
        }
    }
}
}
namespace hg {
constexpr int R144 = 144, R272 = 272;
constexpr int C1_KD = 0, C1_VT = 128 * R144, C1_QT = 2 * 128 * R144, C1_BYTES = C1_QT + 2048;
constexpr int C3_QT = 0, C3_QH = 64 * R272, C3_KH = 2 * 64 * R272, C3_VT = 3 * 64 * R272, C3_ST = C3_VT + 128 * R144, C3_QTOT = C3_ST + 128 * R272, C3_RED = C3_QTOT + 2048, C3_BYTES = C3_RED + 512;

__device__ __forceinline__ void c1_phase(LAS unsigned char* lds, const bf16_t* __restrict__ LF, const bf16_t* __restrict__ VTH, bf16_t* __restrict__ UT, float* __restrict__ DEC, int first, int count, int stride) {
    const int tid = tid_hidden(), wid = __builtin_amdgcn_readfirstlane(tid >> 6), lane = tid & 63, l15 = lane & 15, g4 = lane >> 4;
    const int d = tid & 127, tq = tid >> 7;
    LAS float* qtot = (LAS float*)(lds + C1_QT);
    unsigned lfn[16]; u32x4 vtn[2];
#define C1_PF_LF(ITEM, DIR) do { const int b_ = (ITEM) >> 7, h_ = ((ITEM) >> 5) & 3, j_ = (ITEM) & 31; const size_t tk_ = (size_t)b_ * SEQ + j_ * 64; \
        _Pragma("unroll") for (int i = 0; i < 16; ++i) lfn[i] = (unsigned)((const unsigned short*)LF)[(tk_ + tq * 16 + i) * 1024 + (DIR) * 512 + h_ * 128 + d]; } while (0)
#define C1_PF_VT(ITEM) do { const int b_ = (ITEM) >> 7, h_ = ((ITEM) >> 5) & 3, j_ = (ITEM) & 31; \
        _Pragma("unroll") for (int i = 0; i < 2; ++i) { const int ch = tid + i * 512, e = ch >> 3, part = ch & 7; vtn[i] = *(const u32x4*)(VTH + ((size_t)b_ * 512 + h_ * 128 + e) * SEQ + j_ * 64 + part * 8); } } while (0)
    if (count > 0) { C1_PF_VT(first); C1_PF_LF(first, 0); }
    for (int it = 0; it < count; ++it) {
        const int item = first + it * stride;
        const int b = item >> 7, h = (item >> 5) & 3, j = item & 31;
        __syncthreads();
#pragma unroll
        for (int i = 0; i < 2; ++i) { const int ch = tid + i * 512, e = ch >> 3, part = ch & 7;
            *(LAS u32x4*)(lds + C1_VT + e * R144 + part * 16) = vtn[i]; }
        if (it + 1 < count) C1_PF_VT(item + stride);
#pragma unroll 1
        for (int dir = 0; dir < 2; ++dir) {
            float lfv[16], cs[16];
#pragma unroll
            for (int i = 0; i < 16; ++i) lfv[i] = __uint_as_float(lfn[i] << 16);
            if (dir == 0) C1_PF_LF(item, 1); else if (it + 1 < count) C1_PF_LF(item + stride, 0);
            float run = 0.f;
#pragma unroll
            for (int i = 0; i < 16; ++i) { run += lfv[i]; cs[i] = run; }
            __syncthreads();
            qtot[tq * 128 + d] = run;
            __syncthreads();
            const float q0 = qtot[d], q1 = qtot[128 + d], q2 = qtot[256 + d], q3 = qtot[384 + d];
            const float pre = (tq > 0 ? q0 : 0.f) + (tq > 1 ? q1 : 0.f) + (tq > 2 ? q2 : 0.f), total = (q0 + q1) + (q2 + q3);
            unsigned w[8];
#pragma unroll
            for (int i = 0; i < 16; i += 2) {
                float kd[2];
#pragma unroll
                for (int k = 0; k < 2; ++k) {
                    const float key = 1.f - fexp(lfv[i + k]);
                    const float ex = dir == 0 ? (total - (pre + cs[i + k])) : (pre + cs[i + k] - lfv[i + k]);
                    kd[k] = key * fexp(ex);
                }
                w[i >> 1] = cvt_pk_bf16(kd[0], kd[1]);
            }
            *(LAS u32x4*)(lds + C1_KD + d * R144 + tq * 32) = (u32x4){w[0], w[1], w[2], w[3]};
            *(LAS u32x4*)(lds + C1_KD + d * R144 + tq * 32 + 16) = (u32x4){w[4], w[5], w[6], w[7]};
            const size_t idx = ((size_t)(dir * NB + b) * 4 + h) * 32 + j;
            if (tq == 0) DEC[idx * 128 + d] = fexp(total);
            __syncthreads();
            bf16x8 af[2];
#pragma unroll
            for (int ks = 0; ks < 2; ++ks) af[ks] = *(const LAS bf16x8*)(lds + C1_KD + (wid * 16 + l15) * R144 + ks * 64 + g4 * 16);
#pragma unroll
            for (int et = 0; et < 8; ++et) {
                f32x4 a = (f32x4){0.f, 0.f, 0.f, 0.f};
#pragma unroll
                for (int ks = 0; ks < 2; ++ks) {
                    const bf16x8 bfv = *(const LAS bf16x8*)(lds + C1_VT + (et * 16 + l15) * R144 + ks * 64 + g4 * 16);
                    a = __builtin_amdgcn_mfma_f32_16x16x32_bf16(af[ks], bfv, a, 0, 0, 0);
                }
                u32x2 o; o.x = cvt_pk_bf16(a[0], a[1]); o.y = cvt_pk_bf16(a[2], a[3]);
                *(u32x2*)(UT + idx * 16384 + (size_t)(et * 16 + l15) * 128 + wid * 16 + 4 * g4) = o;
            }
        }
    }
}
#undef C1_PF_LF
#undef C1_PF_VT
__device__ __forceinline__ void c2_phase(const bf16_t* __restrict__ UT, const float* __restrict__ DEC, bf16_t* __restrict__ SIN, int G, int c) {
    for (int w = c * 512 + tid_hidden(); w < 64 * 2048; w += G * 512) {
        const int seq = w >> 11, e = (w >> 4) & 127, d8 = (w & 15) * 8, dir = seq >> 5;
        float S[8];
#pragma unroll
        for (int k = 0; k < 8; ++k) S[k] = 0.f;
#pragma unroll 4
        for (int step = 0; step < 32; ++step) {
            const int j = dir ? 31 - step : step;
            const size_t idx = (size_t)seq * 32 + j;
            const u32x4 u = *(const u32x4*)(UT + idx * 16384 + e * 128 + d8);
            const f32x4 dc0 = *(const f32x4*)(DEC + idx * 128 + d8), dc1 = *(const f32x4*)(DEC + idx * 128 + d8 + 4);
            u32x4 o; o.x = cvt_pk_bf16(S[0], S[1]); o.y = cvt_pk_bf16(S[2], S[3]); o.z = cvt_pk_bf16(S[4], S[5]); o.w = cvt_pk_bf16(S[6], S[7]);
            *(u32x4*)(SIN + idx * 16384 + e * 128 + d8) = o;
            S[0] = dc0[0] * S[0] + __uint_as_float(u.x << 16); S[1] = dc0[1] * S[1] + __uint_as_float(u.x & 0xffff0000u);
            S[2] = dc0[2] * S[2] + __uint_as_float(u.y << 16); S[3] = dc0[3] * S[3] + __uint_as_float(u.y & 0xffff0000u);
            S[4] = dc1[0] * S[4] + __uint_as_float(u.z << 16); S[5] = dc1[1] * S[5] + __uint_as_float(u.z & 0xffff0000u);
            S[6] = dc1[2] * S[6] + __uint_as_float(u.w << 16); S[7] = dc1[3] * S[7] + __uint_as_float(u.w & 0xffff0000u);
        }
    }
}
__device__ __forceinline__ void c3_phase(LAS unsigned char* lds, const bf16_t* __restrict__ QH, const bf16_t* __restrict__ LF, const bf16_t* __restrict__ VTH, const bf16_t* __restrict__ SIN,
                                         const bf16_t* __restrict__ GS, const float* __restrict__ hg_gain, const bf16_t* __restrict__ AO, const float* __restrict__ SSQ,
                                         const float* __restrict__ attn_gain, bf16_t* __restrict__ MIX, int G, int c) {
    const int tid = tid_hidden(), wid = __builtin_amdgcn_readfirstlane(tid >> 6), lane = tid & 63, l15 = lane & 15, g4 = lane >> 4;
    const int d = tid & 127, tq = tid >> 7, tau = wid & 3, eh = wid >> 2;
    LAS float* qtot = (LAS float*)(lds + C3_QTOT);
    LAS float* red = (LAS float*)(lds + C3_RED);
    unsigned lfn[16]; u32x4 stn[4];
#define C3_PREFETCH(ITEM, DIR) do { const int b_ = (ITEM) >> 7, h_ = ((ITEM) >> 5) & 3, j_ = (ITEM) & 31; const size_t tk_ = (size_t)b_ * SEQ + j_ * 64; \
        const size_t ix_ = ((size_t)((DIR) * NB + b_) * 4 + h_) * 32 + j_; \
        _Pragma("unroll") for (int i = 0; i < 16; ++i) lfn[i] = (unsigned)((const unsigned short*)LF)[(tk_ + tq * 16 + i) * 1024 + (DIR) * 512 + h_ * 128 + d]; \
        _Pragma("unroll") for (int i = 0; i < 4; ++i) { const int ch = tid + i * 512, e = ch >> 4, part = ch & 15; stn[i] = *(const u32x4*)(SIN + ix_ * 16384 + e * 128 + part * 8); } } while (0)
    if (c < NB * 4 * 32) C3_PREFETCH(c, 0);
    for (int item = c; item < NB * 4 * 32; item += G) {
        const int b = item >> 7, h = (item >> 5) & 3, j = item & 31;
        const size_t tok0 = (size_t)b * SEQ + j * 64;
        { const int t = tid >> 3, c16 = (tid & 7) * 16; const size_t tok = tok0 + t;
          const f32x4 s0 = *(const f32x4*)(SSQ + tok * 8), s1 = *(const f32x4*)(SSQ + tok * 8 + 4);
          const float r = rsqrtf(((s0[0] + s0[1]) + (s0[2] + s0[3]) + (s1[0] + s1[1]) + (s1[2] + s1[3])) * (1.f / 512) + kf(EPS));
#pragma unroll
          for (int k = 0; k < 2; ++k) {
              const u32x4 a = *(const u32x4*)(AO + tok * 512 + h * 128 + c16 + k * 8);
              const f32x4 g0 = *(const f32x4*)(attn_gain + h * 128 + c16 + k * 8), g1 = *(const f32x4*)(attn_gain + h * 128 + c16 + k * 8 + 4);
              u32x4 o;
              o.x = cvt_pk_bf16(__uint_as_float(a.x << 16) * r * g0[0], __uint_as_float(a.x & 0xffff0000u) * r * g0[1]);
              o.y = cvt_pk_bf16(__uint_as_float(a.y << 16) * r * g0[2], __uint_as_float(a.y & 0xffff0000u) * r * g0[3]);
              o.z = cvt_pk_bf16(__uint_as_float(a.z << 16) * r * g1[0], __uint_as_float(a.z & 0xffff0000u) * r * g1[1]);
              o.w = cvt_pk_bf16(__uint_as_float(a.w << 16) * r * g1[2], __uint_as_float(a.w & 0xffff0000u) * r * g1[3]);
              *(u32x4*)(MIX + tok * D + h * 128 + c16 + k * 8) = o;
          } }
        __syncthreads();
#pragma unroll
        for (int i = 0; i < 2; ++i) { const int ch = tid + i * 512, e = ch >> 3, part = ch & 7;
            *(LAS u32x4*)(lds + C3_VT + e * R144 + part * 16) = *(const u32x4*)(VTH + ((size_t)b * 512 + h * 128 + e) * SEQ + j * 64 + part * 8); }
        f32x4 o[4];
#pragma unroll
        for (int et = 0; et < 4; ++et) o[et] = (f32x4){0.f, 0.f, 0.f, 0.f};
        float qv[16];
#pragma unroll
        for (int i = 0; i < 16; ++i) qv[i] = bf2f(QH[(tok0 + tq * 16 + i) * 512 + h * 128 + d]);
#pragma unroll 1
        for (int dir = 0; dir < 2; ++dir) {
            const size_t idx = ((size_t)(dir * NB + b) * 4 + h) * 32 + j;
            float lfv[16], cs[16]; u32x4 stv[4];
#pragma unroll
            for (int i = 0; i < 16; ++i) lfv[i] = __uint_as_float(lfn[i] << 16);
#pragma unroll
            for (int i = 0; i < 4; ++i) stv[i] = stn[i];
            float run = 0.f;
#pragma unroll
            for (int i = 0; i < 16; ++i) { run += lfv[i]; cs[i] = run; }
            __syncthreads();
            qtot[tq * 128 + d] = run;
#pragma unroll
            for (int i = 0; i < 4; ++i) { const int ch = tid + i * 512, e = ch >> 4, part = ch & 15;
                *(LAS u32x4*)(lds + C3_ST + e * R272 + part * 16) = stv[i]; }
            __syncthreads();
            const float q0 = qtot[d], q1 = qtot[128 + d], q2 = qtot[256 + d], q3 = qtot[384 + d];
            const float pre = (tq > 0 ? q0 : 0.f) + (tq > 1 ? q1 : 0.f) + (tq > 2 ? q2 : 0.f), total = (q0 + q1) + (q2 + q3);
            const float mref = dir == 0 ? (q0 + q1) : (q2 + q3);
#pragma unroll
            for (int i = 0; i < 16; ++i) {
                const int t = tq * 16 + i;
                const float bt = dir == 0 ? (pre + cs[i]) : (total - (pre + cs[i]) + lfv[i]);
                const float q = qv[i];
                const float key = 1.f - fexp(lfv[i]);
                *(LAS bf16_t*)(lds + C3_QT + t * R272 + d * 2) = f2bf(q * fexp(bt));
                *(LAS bf16_t*)(lds + C3_QH + t * R272 + d * 2) = f2bf(q * fexp(fminf(bt - mref, 80.f)));
                *(LAS bf16_t*)(lds + C3_KH + t * R272 + d * 2) = f2bf(key * fexp(fminf(mref - bt, 80.f)));
            }
            __syncthreads();
            if (dir == 0) C3_PREFETCH(item, 1); else if (item + G < NB * 4 * 32) C3_PREFETCH(item + G, 0);
            bf16x8 qf[4];
#pragma unroll
            for (int ks = 0; ks < 4; ++ks) qf[ks] = *(const LAS bf16x8*)(lds + C3_QH + (tau * 16 + l15) * R272 + ks * 64 + g4 * 16);
            f32x4 sc[4];
#pragma unroll
            for (int sg = 0; sg < 4; ++sg) {
                f32x4 a = (f32x4){0.f, 0.f, 0.f, 0.f};
                const bool need = dir == 0 ? (sg <= tau) : (sg >= tau);
                if (need) {
#pragma unroll
                    for (int ks = 0; ks < 4; ++ks) {
                        const bf16x8 kf = *(const LAS bf16x8*)(lds + C3_KH + (sg * 16 + l15) * R272 + ks * 64 + g4 * 16);
                        a = __builtin_amdgcn_mfma_f32_16x16x32_bf16(kf, qf[ks], a, 0, 0, 0);
                    }
#pragma unroll
                    for (int r = 0; r < 4; ++r) { const int sp = sg * 16 + 4 * g4 + r, tp = tau * 16 + l15; const bool ok = dir == 0 ? (sp <= tp) : (sp >= tp); a[r] = ok ? a[r] : 0.f; }
                }
                sc[sg] = a;
            }
#pragma unroll
            for (int ks = 0; ks < 4; ++ks) qf[ks] = *(const LAS bf16x8*)(lds + C3_QT + (tau * 16 + l15) * R272 + ks * 64 + g4 * 16);
#pragma unroll
            for (int et = 0; et < 4; ++et) {
                const int erow = (eh * 4 + et) * 16 + l15;
#pragma unroll
                for (int up = 0; up < 2; ++up) {
                    u32x4 pw; pw.x = cvt_pk_bf16(sc[2 * up][0], sc[2 * up][1]); pw.y = cvt_pk_bf16(sc[2 * up][2], sc[2 * up][3]);
                    pw.z = cvt_pk_bf16(sc[2 * up + 1][0], sc[2 * up + 1][1]); pw.w = cvt_pk_bf16(sc[2 * up + 1][2], sc[2 * up + 1][3]);
                    const LAS unsigned char* vp = lds + C3_VT + erow * R144 + (up * 32 + 4 * g4) * 2;
                    const u32x2 va = *(const LAS u32x2*)vp, vb = *(const LAS u32x2*)(vp + 32);
                    o[et] = __builtin_amdgcn_mfma_f32_16x16x32_bf16(__builtin_bit_cast(bf16x8, (u32x4){va.x, va.y, vb.x, vb.y}), __builtin_bit_cast(bf16x8, pw), o[et], 0, 0, 0);
                }
#pragma unroll
                for (int ks = 0; ks < 4; ++ks) {
                    const bf16x8 sf = *(const LAS bf16x8*)(lds + C3_ST + erow * R272 + ks * 64 + g4 * 16);
                    o[et] = __builtin_amdgcn_mfma_f32_16x16x32_bf16(sf, qf[ks], o[et], 0, 0, 0);
                }
            }
        }
        float ss = 0.f;
#pragma unroll
        for (int et = 0; et < 4; ++et) ss += o[et][0] * o[et][0] + o[et][1] * o[et][1] + o[et][2] * o[et][2] + o[et][3] * o[et][3];
        ss += shx(ss, 16); ss += shx(ss, 32);
        if (g4 == 0) red[wid * 16 + l15] = ss;
        __syncthreads();
        const float tot = red[wid * 16 + l15] + red[(wid ^ 4) * 16 + l15];
        const float rr = rsqrtf(tot * (1.f / 128) + kf(EPS));
        const size_t tok = tok0 + tau * 16 + l15;
#pragma unroll
        for (int et = 0; et < 4; ++et) {
            const int e0 = (eh * 4 + et) * 16 + 4 * g4;
            const f32x4 gn = *(const f32x4*)(hg_gain + e0);
            const u32x2 gv = *(const u32x2*)(GS + tok * 512 + h * 128 + e0);
            u32x2 w;
            w.x = cvt_pk_bf16(o[et][0] * rr * gn[0] * __uint_as_float(gv.x << 16), o[et][1] * rr * gn[1] * __uint_as_float(gv.x & 0xffff0000u));
            w.y = cvt_pk_bf16(o[et][2] * rr * gn[2] * __uint_as_float(gv.y << 16), o[et][3] * rr * gn[3] * __uint_as_float(gv.y & 0xffff0000u));
            *(u32x2*)(MIX + tok * D + 512 + h * 128 + e0) = w;
        }
    }
}
#undef C3_PREFETCH
}

#define XB_TMO      128
#define XB_XCNT(j)  (256  + 64 * (j))
#define XB_XSUB(j)  (1280 + 64 * (j))
#define XB_XGEN(j)  (2304 + 64 * (j))
#define XB_TOP      3328
#define XB_TOPGEN   3392
#define XCD_BAR_WORDS 3456
#define XB_SPIN_CAP (1u << 18)
__device__ __forceinline__ unsigned xb_xcc_id() { return (unsigned)__builtin_amdgcn_s_getreg((3 << 11) | 20) & 0xFu; }
#define XB_SPIN(cond, bar) do { unsigned _sp = 0; while (cond) { __builtin_amdgcn_s_sleep(1); \
    if ((++_sp & 255u) == 0u) { if (xb_ld(&(bar)[XB_TMO])) break; if (_sp > XB_SPIN_CAP) { (void)xb_add(&(bar)[XB_TMO], 1u); break; } } } } while (0)
struct XcdBarrier { unsigned* bar; unsigned x; volatile LAS unsigned* st; };
__device__ __forceinline__ XcdBarrier xcd_barrier_post(unsigned* bar, volatile LAS unsigned* st) {
    XcdBarrier b; b.bar = bar; b.x = xb_xcc_id(); b.st = st;
    if (threadIdx.x == 0) (void)xb_add(&bar[XB_XCNT(b.x)], 1u);
    return b;
}
__device__ __forceinline__ void xcd_barrier_complete(unsigned* bar, unsigned x, unsigned& nloc, unsigned& nx) {
    const unsigned G = gridDim.x * gridDim.y * gridDim.z;
    unsigned sum, cnt, sp = 0u;
    for (;;) {
        sum = 0u; cnt = 0u;
#pragma unroll 1
        for (unsigned j = 0; j < 16; ++j) { const unsigned c = xb_ld(&bar[XB_XCNT(j)]); sum += c; cnt += (c > 0u) ? 1u : 0u; }
        if (sum == G) break;
        __builtin_amdgcn_s_sleep(1);
        if ((++sp & 255u) == 0u) { if (xb_ld(&bar[XB_TMO])) break; if (sp > XB_SPIN_CAP) { (void)xb_add(&bar[XB_TMO], 1u); break; } }
    }
    const unsigned mine = xb_ld(&bar[XB_XCNT(x)]);
    nloc = mine > 0u ? mine : 1u; nx = cnt > 0u ? cnt : 1u;
}
__device__ __forceinline__ void xcd_barrier(const XcdBarrier& b) {
    asm volatile("s_waitcnt vmcnt(0)" ::: "memory");
    __syncthreads();
    if (threadIdx.x == 0) {
        unsigned* bar = b.bar;
        __builtin_amdgcn_s_waitcnt(0);
        unsigned nloc = b.st[0], nx = b.st[1];
        if (nloc == 0u) { xcd_barrier_complete(bar, b.x, nloc, nx); b.st[0] = nloc; b.st[1] = nx; }
        const unsigned old = xb_add(&bar[XB_XSUB(b.x)], 1u);
        const unsigned gen = old / nloc;
        if (old + 1u == (gen + 1u) * nloc) {
            __builtin_amdgcn_fence(__ATOMIC_RELEASE, "agent");
            asm volatile("s_waitcnt vmcnt(0)" ::: "memory");
            const unsigned og = xb_add(&bar[XB_TOP], 1u);
            const unsigned tg = og / nx;
            if (og + 1u == (tg + 1u) * nx) xb_add(&bar[XB_TOPGEN], 1u);
            else XB_SPIN(xb_ld(&bar[XB_TOPGEN]) == tg, bar);
            __builtin_amdgcn_fence(__ATOMIC_ACQUIRE, "agent");
            xb_add(&bar[XB_XGEN(b.x)], 1u);
            asm volatile("s_waitcnt vmcnt(0)" ::: "memory");
        } else {
            XB_SPIN(xb_ld(&bar[XB_XGEN(b.x)]) == gen, bar);
            __builtin_amdgcn_fence(__ATOMIC_ACQUIRE, "agent");
            asm volatile("s_waitcnt vmcnt(0)" ::: "memory");
        }
    }
    __syncthreads();
}

constexpr size_t al(size_t x) { return (x + 255) & ~(size_t)255; }
constexpr size_t CTL_BYTES = 32768;
constexpr size_t W_CNT = 13824;
constexpr size_t W_DONE = 16384;
constexpr size_t W_X = CTL_BYTES;
constexpr size_t W_H1B = W_X + al((size_t)T * D * 4);
constexpr size_t W_MIXB = W_H1B + al((size_t)T * D * 2);
constexpr size_t W_H2B = W_MIXB + al((size_t)T * D * 2);
constexpr size_t W_QA = W_H2B + al((size_t)T * D * 2);
constexpr size_t W_KA = W_QA + al((size_t)T * 512 * 2);
constexpr size_t W_VTA = W_KA + al((size_t)T * 128 * 2);
constexpr size_t W_QH = W_VTA + al((size_t)T * 128 * 2);
constexpr size_t W_LF = W_QH + al((size_t)T * 512 * 2);
constexpr size_t W_VTH = W_LF + al((size_t)T * 1024 * 4);
constexpr size_t W_GS = W_VTH + al((size_t)T * 512 * 2);
constexpr size_t W_AO = W_GS + al((size_t)T * 512 * 2);
constexpr size_t W_SSQ = W_AO + al((size_t)T * 512 * 2);
constexpr size_t W_UT = W_SSQ + al((size_t)T * 8 * 4);
constexpr size_t W_SIN = W_UT + al((size_t)2048 * 16384 * 2);
constexpr size_t W_DEC = W_SIN + al((size_t)2048 * 16384 * 2);
constexpr size_t W_MOD = W_DEC + al((size_t)2048 * 128 * 4);
constexpr size_t W_LOW = W_MOD + al((size_t)DEPTH * NB * 6 * D * 4);
constexpr size_t W_ROPE = W_LOW + al((size_t)DEPTH * 1024 * 4);
constexpr size_t W_WRP = W_ROPE + al((size_t)T * 16 * 4);
constexpr size_t W_BRP = W_WRP + al((size_t)DEPTH * NB * D * NE * 4);
constexpr size_t W_LTOK = W_BRP + al((size_t)DEPTH * NB * NE * 4);
constexpr size_t W_LGATE = W_LTOK + al((size_t)NE * T * 4);
constexpr size_t W_PE = W_LGATE + al((size_t)NE * T * 4);
constexpr size_t W_PR = W_PE + al((size_t)NP * 4);
constexpr size_t W_ACTB = W_PR + al((size_t)NP * 4);
constexpr size_t W_YB = W_ACTB + al((size_t)(NP + NE * 256) * 1024 * 2);
constexpr size_t W_WINT = W_YB + al((size_t)(NP + NE * 256) * 1024 * 2);
constexpr size_t W_WOUTT = W_WINT + al((size_t)DEPTH * INW * 1024 * 2);
constexpr size_t W_WGUT = W_WOUTT + al((size_t)DEPTH * D * 1024 * 2);
constexpr size_t W_WDT = W_WGUT + al((size_t)DEPTH * NE * 2048 * 1024 * 2);
constexpr size_t W_END = W_WDT + al((size_t)DEPTH * NE * 1024 * 1024 * 2);

constexpr int LDS_BAR_OFF = g8::LDS_TOTAL - 64;

struct Args {
    const float* x; const float* c; const int* pos; const float* w_ada; const float* b_ada; const float* norm1; const float* w_in; const float* sink;
    const float* attn_norm; const float* lbl; const float* hg_norm; const float* w_out; const float* norm2; const float* w_router; const float* b_router;
    const float* w_gu; const float* b_gu; const float* w_down; const float* b_down; const float* final_norm;
    float* out; unsigned char* ws; int ph_lo, ph_hi;
};

struct ArgsG {
    const float GAS* x; const float GAS* c; const int GAS* pos; const float GAS* w_ada; const float GAS* b_ada; const float GAS* norm1; const float GAS* w_in; const float GAS* sink;
    const float GAS* attn_norm; const float GAS* lbl; const float GAS* hg_norm; const float GAS* w_out; const float GAS* norm2; const float GAS* w_router; const float GAS* b_router;
    const float GAS* w_gu; const float GAS* b_gu; const float GAS* w_down; const float GAS* b_down; const float GAS* final_norm;
    float GAS* out; unsigned char GAS* ws; int ph_lo, ph_hi;
};
static_assert(sizeof(ArgsG) == sizeof(Args), "ArgsG layout");
typedef const ArgsG __attribute__((address_space(4)))* ArgsP;
__device__ __forceinline__ ArgsP args_hidden() { ArgsP p = (ArgsP)__builtin_amdgcn_kernarg_segment_ptr(); asm volatile("" : "+s"(p)); return p; }
#define ARG(f) (args_hidden()->f)
template <class Tp> __device__ __forceinline__ Tp* to_generic(Tp GAS* p) { return (Tp*)p; }
#define ARGP(f) to_generic(args_hidden()->f)
__device__ __forceinline__ float siluf_(float v) { return v / (1.f + fexp(-v)); }

__device__ __forceinline__ void ada_phase(LAS unsigned char* lds, const float* __restrict__ cin, const float* __restrict__ w_ada, const float* __restrict__ b_ada, float* __restrict__ MOD, int G, int c) {
    LAS float* cond = (LAS float*)lds; LAS float* part = (LAS float*)(lds + 32768);
    const int tid = tid_hidden();
    __syncthreads();
    for (int i = tid; i < NB * D; i += 512) cond[i] = siluf_(cin[i]);
    __syncthreads();
    for (int cb = c; cb < 256; cb += G) {
        const int col0 = cb * 96, l = col0 / (6 * D), j0 = col0 - l * 6 * D;
        if (tid < 384) {
            const int cl = tid % 96, kp = tid / 96;
            const float* w = w_ada + ((size_t)l * D + kp * 256) * 6 * D + j0 + cl;
            float acc[NB];
#pragma unroll
            for (int b = 0; b < NB; ++b) acc[b] = 0.f;
#pragma unroll 16
            for (int k = 0; k < 256; ++k) {
                const float wv = w[(size_t)k * 6 * D];
#pragma unroll
                for (int b = 0; b < NB; ++b) acc[b] += cond[b * D + kp * 256 + k] * wv;
            }
#pragma unroll
            for (int b = 0; b < NB; ++b) part[(kp * 96 + cl) * 8 + b] = acc[b];
        }
        __syncthreads();
        for (int o = tid; o < 96 * 8; o += 512) {
            const int cl = o >> 3, b = o & 7;
            const float s = part[(0 * 96 + cl) * 8 + b] + part[(1 * 96 + cl) * 8 + b] + part[(2 * 96 + cl) * 8 + b] + part[(3 * 96 + cl) * 8 + b] + b_ada[l * 6 * D + j0 + cl];
            MOD[((size_t)l * NB + b) * 6 * D + j0 + cl] = s;
        }
        __syncthreads();
    }
}
__device__ __forceinline__ void misc_phase(const float* __restrict__ lbl, const int* __restrict__ pos, float* __restrict__ lower, float* __restrict__ rope, int G, int c) {
    for (int gid = c * 512 + tid_hidden(); gid < T * 8; gid += G * 512) {
        if (gid < 1024) {
            float v0 = lbl[gid], v1 = lbl[1024 + gid], v2 = lbl[2048 + gid], v3 = lbl[3072 + gid];
            const float m = fmaxf(fmaxf(v0, v1), fmaxf(v2, v3));
            v0 = expf(v0 - m); v1 = expf(v1 - m); v2 = expf(v2 - m); v3 = expf(v3 - m);
            const float s = (v0 + v1) + (v2 + v3);
            lower[gid] = 0.f; lower[1024 + gid] = v1 / s; lower[2048 + gid] = v1 / s + v2 / s; lower[3072 + gid] = v1 / s + v2 / s + v3 / s;
        }
        const int t = gid >> 3, i = gid & 7;
        const double inv = pow(500000.0, -(double)i / 8.0);
        const double ang = (double)((float)pos[t]) * (double)((float)inv);
        rope[t * 16 + i] = (float)cos(ang);
        rope[t * 16 + 8 + i] = (float)sin(ang);
    }
}
__device__ __forceinline__ void conv_load(f32x4 (&v)[8], const float* __restrict__ sp, int N, int kt, int nt, int mode, int tid) {
    const int n4 = (tid & 15) * 4, kr = tid >> 4;
    int scol = nt * 64 + n4;
    if (mode == 1) { const int pn = scol >> 8, u = scol & 255, w = u & 127, rho = w & 31; scol = (u >> 7) * 1024 + pn * 128 + (w & ~31) + 8 * ((rho & 15) >> 2) + 4 * (rho >> 4); }
    if (mode == 2) { const int rho = scol & 31; scol = (scol & ~31) + 8 * ((rho & 15) >> 2) + 4 * (rho >> 4); }
#pragma unroll
    for (int i = 0; i < 8; ++i) v[i] = __builtin_nontemporal_load((const f32x4*)(sp + (size_t)(kt * 128 + kr + 16 * i) * N + scol));
}
__device__ __forceinline__ void conv_put(LAS float* tile, const f32x4 (&v)[8], int tid) {
    const int n4 = (tid & 15) * 4, kr = tid >> 4;
#pragma unroll
    for (int i = 0; i < 8; ++i)
#pragma unroll
        for (int j = 0; j < 4; ++j) tile[(kr + 16 * i) * 65 + n4 + j] = v[i][j];
}
__device__ __forceinline__ void conv_tile_out(LAS const float* tile, bf16_t* __restrict__ dp, int kt, int nt, int tid) {
    const int n = tid >> 2, kc = (tid & 3) * 32;
    bf16_t* o = dp + (size_t)(nt * 64 + n) * 1024 + kt * 128 + kc;
#pragma unroll
    for (int h = 0; h < 4; ++h) {
        unsigned w[4];
#pragma unroll
        for (int i = 0; i < 4; ++i) w[i] = cvt_pk_bf16(tile[(kc + h * 8 + 2 * i) * 65 + n], tile[(kc + h * 8 + 2 * i + 1) * 65 + n]);
        *(u32x4*)(o + h * 8) = (u32x4){w[0], w[1], w[2], w[3]};
    }
}
__device__ __forceinline__ void conv_tile_out8(LAS const float* tile, unsigned char* __restrict__ dp, int kt, int nt, int tid) {
    const int n = tid >> 2, kc = (tid & 3) * 32;
    unsigned char* o = dp + (size_t)(nt * 64 + n) * 1024 + kt * 128 + kc;
#pragma unroll
    for (int h = 0; h < 2; ++h) {
        unsigned w[4];
#pragma unroll
        for (int i = 0; i < 4; ++i) { const int k = kc + h * 16 + 4 * i; w[i] = cvt_pk4_fp8(tile[k * 65 + n] * W8_SCALE, tile[(k + 1) * 65 + n] * W8_SCALE, tile[(k + 2) * 65 + n] * W8_SCALE, tile[(k + 3) * 65 + n] * W8_SCALE); }
        *(u32x4*)(o + h * 16) = (u32x4){w[0], w[1], w[2], w[3]};
    }
}
struct ConvJob { const float* sp; unsigned char* dp; int N, kt, nt, mode, f8; };
__device__ __forceinline__ bool conv_job(int it, int half, const float* __restrict__ w_in, const float* __restrict__ w_out, const float* __restrict__ w_gu, const float* __restrict__ w_down, unsigned char* ws, ConvJob& jb) {
    constexpr int T_IN = 8 * 52, T_OUT = 8 * 16, T_GU = NE * 8 * 32, T_DN = NE * 8 * 16, T_L = T_IN + T_OUT + T_GU + T_DN;
    if (it * 2 >= DEPTH * T_L) return false;
    const int ti = it * 2 + half;
    const int l = ti / T_L; int r = ti - l * T_L;
    jb.mode = 0; jb.f8 = 0;
    if (r < T_IN) { jb.sp = w_in + (size_t)l * D * INW; jb.dp = ws + W_WINT + (size_t)l * INW * 2048; jb.N = INW; jb.mode = 2; }
    else if ((r -= T_IN) < T_OUT) { jb.sp = w_out + (size_t)l * D * D; jb.dp = ws + W_WOUTT + (size_t)l * D * 2048; jb.N = D; jb.mode = 2; }
    else if ((r -= T_OUT) < T_GU) { const int m = r / 256; r -= m * 256; jb.sp = w_gu + ((size_t)l * NE + m) * D * 2048; jb.dp = ws + W_WGUT + ((size_t)l * NE + m) * 2048 * 1024; jb.N = 2048; jb.mode = 1; jb.f8 = 1; }
    else { r -= T_GU; const int m = r / 128; r -= m * 128; jb.sp = w_down + ((size_t)l * NE + m) * DFF * D; jb.dp = ws + W_WDT + ((size_t)l * NE + m) * D * 1024; jb.N = D; jb.mode = 2; jb.f8 = 1; }
    const int tn = jb.N / 64; jb.kt = r / tn; jb.nt = r - jb.kt * tn;
    return true;
}
__device__ __forceinline__ void conv_finish(LAS float* tile, const f32x4 (&v)[8], const ConvJob& jb, int t256) {
    asm volatile("s_waitcnt lgkmcnt(0)" ::: "memory"); __builtin_amdgcn_s_barrier();
    conv_put(tile, v, t256);
    asm volatile("s_waitcnt lgkmcnt(0)" ::: "memory"); __builtin_amdgcn_s_barrier();
    if (jb.f8) conv_tile_out8(tile, jb.dp, jb.kt, jb.nt, t256); else conv_tile_out(tile, (bf16_t*)jb.dp, jb.kt, jb.nt, t256);
}
__device__ __forceinline__ void conv_phase(LAS unsigned char* lds, const float* __restrict__ w_in, const float* __restrict__ w_out, const float* __restrict__ w_gu, const float* __restrict__ w_down, unsigned char* ws, int G, int c) {
    const int tid = tid_hidden(), half = tid >> 8, t256 = tid & 255;
    LAS float* tile = (LAS float*)(lds + half * 33280);
    ConvJob j0, j1, j2; f32x4 v0[8], v1[8], v2[8];
    int it = c;
    bool h0 = conv_job(it, half, w_in, w_out, w_gu, w_down, ws, j0); if (h0) conv_load(v0, j0.sp, j0.N, j0.kt, j0.nt, j0.mode, t256); it += G;
    bool h1 = conv_job(it, half, w_in, w_out, w_gu, w_down, ws, j1); if (h1) conv_load(v1, j1.sp, j1.N, j1.kt, j1.nt, j1.mode, t256); it += G;
    for (;;) {
        const bool h2 = conv_job(it, half, w_in, w_out, w_gu, w_down, ws, j2); if (h2) conv_load(v2, j2.sp, j2.N, j2.kt, j2.nt, j2.mode, t256); it += G;
        if (!h0) break;
        conv_finish(tile, v0, j0, t256);
        h0 = conv_job(it, half, w_in, w_out, w_gu, w_down, ws, j0); if (h0) conv_load(v0, j0.sp, j0.N, j0.kt, j0.nt, j0.mode, t256); it += G;
        if (!h1) break;
        conv_finish(tile, v1, j1, t256);
        h1 = conv_job(it, half, w_in, w_out, w_gu, w_down, ws, j1); if (h1) conv_load(v1, j1.sp, j1.N, j1.kt, j1.nt, j1.mode, t256); it += G;
        if (!h2) break;
        conv_finish(tile, v2, j2, t256);
    }
    __syncthreads();
}
__device__ __forceinline__ void wrp_phase(const float* __restrict__ norm2, const float* __restrict__ w_router, const float* __restrict__ b_router, unsigned char* ws, int G, int c) {
    const float* MOD = (const float*)(ws + W_MOD); float* WRP = (float*)(ws + W_WRP); float* BRP = (float*)(ws + W_BRP);
    const int tid = tid_hidden();
    for (int i = c * 512 + tid; i < DEPTH * NB * D * NE; i += G * 512) {
        const int e = i & 31, k = (i >> 5) & 1023, b = (i >> 15) & 7, l = i >> 18;
        const float sc = MOD[((size_t)l * NB + b) * 6 * D + 4 * D + k];
        const float wv = norm2[l * D + k] * (1.f + sc) * w_router[((size_t)l * D + k) * NE + e];
        const bf16_t hi = f2bf(wv), lo = f2bf(wv - bf2f(hi));
        bf16_t* WH = (bf16_t*)WRP; bf16_t* WL = WH + (size_t)DEPTH * NB * D * NE;
        const size_t wi = ((size_t)(l * NB + b) * 128 + (k >> 3)) * 256 + e * 8 + (k & 7);
        WH[wi] = hi; WL[wi] = lo;
    }
    const int wid = tid >> 6, lane = tid & 63;
    for (int o = c * 8 + wid; o < DEPTH * NB * NE; o += G * 8) {
        const int e = o & 31, b = (o >> 5) & 7, l = o >> 8;
        float s = 0.f;
        for (int k = lane; k < D; k += 64) s += MOD[((size_t)l * NB + b) * 6 * D + 3 * D + k] * w_router[((size_t)l * D + k) * NE + e];
        for (int of = 32; of > 0; of >>= 1) s += shx(s, of);
        if (lane == 0) BRP[o] = s + b_router[l * NE + e];
    }
}
__device__ __forceinline__ void norm_phase(const float* __restrict__ X, const float* __restrict__ gain, const float* __restrict__ mod_l, int sh_off, int sc_off, bf16_t* __restrict__ H, bf16_t* __restrict__ Xb, int G, int c) {
    const int tidh = tid_hidden(), wid = tidh >> 6, lane = tidh & 63;
    for (int blk = c; blk < T / 64; blk += G) {
        const int t0 = blk * 64 + wid * 8, b = t0 / SEQ, k0 = lane * 16;
        const float* mb = mod_l + (size_t)b * 6 * D;
        f32x4 gn[4], sh[4];
#pragma unroll
        for (int q = 0; q < 4; ++q) { const f32x4 g = *(const f32x4*)(gain + k0 + 4 * q), sc = *(const f32x4*)(mb + sc_off + k0 + 4 * q); sh[q] = *(const f32x4*)(mb + sh_off + k0 + 4 * q); gn[q] = g * (sc + 1.f); }
#pragma unroll 4
        for (int i = 0; i < 8; ++i) {
            const size_t t = (size_t)t0 + i;
            f32x4 v[4]; float ss = 0.f;
#pragma unroll
            for (int q = 0; q < 4; ++q) { v[q] = *(const f32x4*)(X + t * D + k0 + 4 * q); ss += v[q][0] * v[q][0] + v[q][1] * v[q][1] + v[q][2] * v[q][2] + v[q][3] * v[q][3]; }
            for (int of = 32; of > 0; of >>= 1) ss += shx(ss, of);
            const float r = rsqrtf(ss * (1.f / D) + kf(EPS));
            u32x4 x0, x1, h0, h1;
            x0.x = cvt_pk_bf16(v[0][0], v[0][1]); x0.y = cvt_pk_bf16(v[0][2], v[0][3]); x0.z = cvt_pk_bf16(v[1][0], v[1][1]); x0.w = cvt_pk_bf16(v[1][2], v[1][3]);
            x1.x = cvt_pk_bf16(v[2][0], v[2][1]); x1.y = cvt_pk_bf16(v[2][2], v[2][3]); x1.z = cvt_pk_bf16(v[3][0], v[3][1]); x1.w = cvt_pk_bf16(v[3][2], v[3][3]);
            *(u32x4*)(Xb + t * D + k0) = x0; *(u32x4*)(Xb + t * D + k0 + 8) = x1;
            f32x4 o[4];
#pragma unroll
            for (int q = 0; q < 4; ++q) o[q] = v[q] * r * gn[q] + sh[q];
            h0.x = cvt_pk_bf16(o[0][0], o[0][1]); h0.y = cvt_pk_bf16(o[0][2], o[0][3]); h0.z = cvt_pk_bf16(o[1][0], o[1][1]); h0.w = cvt_pk_bf16(o[1][2], o[1][3]);
            h1.x = cvt_pk_bf16(o[2][0], o[2][1]); h1.y = cvt_pk_bf16(o[2][2], o[2][3]); h1.z = cvt_pk_bf16(o[3][0], o[3][1]); h1.w = cvt_pk_bf16(o[3][2], o[3][3]);
            *(u32x4*)(H + t * D + k0) = h0; *(u32x4*)(H + t * D + k0 + 8) = h1;
        }
    }
}

namespace rt {
typedef float f32x16 __attribute__((ext_vector_type(16)));
constexpr int XRB = 2064;
constexpr int XT_BYTES = 64 * XRB;
constexpr int O_RS = XT_BYTES, O_LG = O_RS + 256, O_SE = O_LG + 64 * 33 * 4, O_SG = O_SE + 1024, O_SR = O_SG + 1024, O_LC = O_SR + 1024, O_BASE = O_LC + 128, O_ENDR = O_BASE + 128;
static_assert(O_ENDR <= LDS_BAR_OFF, "router LDS map");
__device__ __forceinline__ void router_phase(LAS unsigned char* lds, const bf16_t* __restrict__ X, const float* __restrict__ gain, const float* __restrict__ mod_l,
                                             const bf16_t* __restrict__ WH_l, const bf16_t* __restrict__ WL_l, const float* __restrict__ BRP_l, bf16_t* __restrict__ H2B, int* __restrict__ cnt_l,
                                             int* __restrict__ LTOK, float* __restrict__ LGATE, int* __restrict__ PE, int* __restrict__ PR, int G, int c) {
    const int tid = tid_hidden(), wid = __builtin_amdgcn_readfirstlane(tid >> 6), lane = tid & 63;
    LAS float* rs = (LAS float*)(lds + O_RS); LAS float* lg = (LAS float*)(lds + O_LG);
    LAS int* se = (LAS int*)(lds + O_SE); LAS float* sg = (LAS float*)(lds + O_SG); LAS int* sr = (LAS int*)(lds + O_SR);
    LAS int* lc = (LAS int*)(lds + O_LC); LAS int* base = (LAS int*)(lds + O_BASE);
    for (int blk = c; blk < T / 64; blk += G) {
        const int tok0 = blk * 64, b = tok0 / SEQ;
        const float* mb = mod_l + (size_t)b * 6 * D;
        u32x4 xr[16];
#pragma unroll
        for (int i = 0; i < 16; ++i) { const int idx = tid + i * 512, r = idx >> 7, c8 = idx & 127; xr[i] = *(const u32x4*)(X + (size_t)(tok0 + r) * D + c8 * 8); }
        const int r31 = lane & 31, kg = lane >> 5;
        f32x4 mg[4], ms[4];
#pragma unroll
        for (int q = 0; q < 4; ++q) { const int k = lane * 16 + q * 4;
            const f32x4 g = *(const f32x4*)(gain + k), sc = *(const f32x4*)(mb + 4 * D + k), sh = *(const f32x4*)(mb + 3 * D + k);
            mg[q] = g * (sc + 1.f) * H28_SCALE; ms[q] = sh * H28_SCALE; }
        __syncthreads();
        if (tid < 32) lc[tid] = 0;
#pragma unroll
        for (int i = 0; i < 16; ++i) { const int idx = tid + i * 512, r = idx >> 7, c8 = idx & 127; *(LAS u32x4*)(lds + r * XRB + c8 * 16) = xr[i]; }
        bf16x8 bh[8], bl[8];
#pragma unroll
        for (int i = 0; i < 8; ++i) { const size_t o = ((size_t)b * 128 + wid * 16 + i * 2 + kg) * 256 + r31 * 8; bh[i] = *(const bf16x8*)(WH_l + o); bl[i] = *(const bf16x8*)(WL_l + o); }
        asm volatile("s_waitcnt lgkmcnt(0)" ::: "memory"); __builtin_amdgcn_s_barrier();
#pragma unroll 1
        for (int hb = 0; hb < 4; ++hb) {
            f32x4 v[2][4]; float ss[2];
#pragma unroll
            for (int rr = 0; rr < 2; ++rr) { const int r = wid * 8 + hb * 2 + rr;
                const u32x4 w0 = *(const LAS u32x4*)(lds + r * XRB + lane * 32), w1 = *(const LAS u32x4*)(lds + r * XRB + lane * 32 + 16);
                v[rr][0] = (f32x4){__uint_as_float(w0.x << 16), __uint_as_float(w0.x & 0xffff0000u), __uint_as_float(w0.y << 16), __uint_as_float(w0.y & 0xffff0000u)};
                v[rr][1] = (f32x4){__uint_as_float(w0.z << 16), __uint_as_float(w0.z & 0xffff0000u), __uint_as_float(w0.w << 16), __uint_as_float(w0.w & 0xffff0000u)};
                v[rr][2] = (f32x4){__uint_as_float(w1.x << 16), __uint_as_float(w1.x & 0xffff0000u), __uint_as_float(w1.y << 16), __uint_as_float(w1.y & 0xffff0000u)};
                v[rr][3] = (f32x4){__uint_as_float(w1.z << 16), __uint_as_float(w1.z & 0xffff0000u), __uint_as_float(w1.w << 16), __uint_as_float(w1.w & 0xffff0000u)};
                ss[rr] = 0.f;
#pragma unroll
                for (int q = 0; q < 4; ++q) ss[rr] += v[rr][q][0] * v[rr][q][0] + v[rr][q][1] * v[rr][q][1] + v[rr][q][2] * v[rr][q][2] + v[rr][q][3] * v[rr][q][3]; }
            for (int of = 32; of > 0; of >>= 1) {
#pragma unroll
                for (int rr = 0; rr < 2; ++rr) ss[rr] += shx(ss[rr], of);
            }
#pragma unroll
            for (int rr = 0; rr < 2; ++rr) {
                const int r = wid * 8 + hb * 2 + rr; const size_t t = (size_t)tok0 + r;
                const float rstd = rsqrtf(ss[rr] * (1.f / D) + kf(EPS));
                if (lane == 0) rs[r] = rstd;
                u32x4 hw;
                { const f32x4 o = v[rr][0] * rstd * mg[0] + ms[0]; hw.x = cvt_pk4_fp8(o[0], o[1], o[2], o[3]); }
                { const f32x4 o = v[rr][1] * rstd * mg[1] + ms[1]; hw.y = cvt_pk4_fp8(o[0], o[1], o[2], o[3]); }
                { const f32x4 o = v[rr][2] * rstd * mg[2] + ms[2]; hw.z = cvt_pk4_fp8(o[0], o[1], o[2], o[3]); }
                { const f32x4 o = v[rr][3] * rstd * mg[3] + ms[3]; hw.w = cvt_pk4_fp8(o[0], o[1], o[2], o[3]); }
                *(u32x4*)((unsigned char*)H2B + t * D + lane * 16) = hw;
            }
        }
        f32x16 acc0, acc1;
#pragma unroll
        for (int i = 0; i < 16; ++i) { acc0[i] = 0.f; acc1[i] = 0.f; }
#pragma unroll
        for (int i = 0; i < 8; ++i) {
            const bf16x8 a0 = *(const LAS bf16x8*)(lds + r31 * XRB + (wid * 128 + i * 16 + kg * 8) * 2);
            const bf16x8 a1 = *(const LAS bf16x8*)(lds + (32 + r31) * XRB + (wid * 128 + i * 16 + kg * 8) * 2);
            acc0 = __builtin_amdgcn_mfma_f32_32x32x16_bf16(a0, bh[i], acc0, 0, 0, 0);
            acc1 = __builtin_amdgcn_mfma_f32_32x32x16_bf16(a1, bh[i], acc1, 0, 0, 0);
            acc0 = __builtin_amdgcn_mfma_f32_32x32x16_bf16(a0, bl[i], acc0, 0, 0, 0);
            acc1 = __builtin_amdgcn_mfma_f32_32x32x16_bf16(a1, bl[i], acc1, 0, 0, 0);
        }
        __syncthreads();
        LAS float* part = (LAS float*)lds;
#pragma unroll
        for (int i = 0; i < 16; ++i) { part[(wid * 2 + 0) * 1024 + i * 64 + lane] = acc0[i]; part[(wid * 2 + 1) * 1024 + i * 64 + lane] = acc1[i]; }
        __syncthreads();
#pragma unroll
        for (int j = 0; j < 4; ++j) {
            const int o = tid + j * 512, rg = o >> 10, reg = (o >> 6) & 15, ln = o & 63;
            float sm = 0.f;
#pragma unroll
            for (int w = 0; w < 8; ++w) sm += part[(w * 2 + rg) * 1024 + reg * 64 + ln];
            const int e = ln & 31, row = rg * 32 + (reg & 3) + 8 * (reg >> 2) + 4 * (ln >> 5);
            lg[row * 33 + e] = sm * rs[row] + BRP_l[b * NE + e];
        }
        __syncthreads();
        if (tid < 64) {
            const int row = tid; unsigned used = 0u; int idx[4]; float val[4];
#pragma unroll
            for (int k = 0; k < 4; ++k) {
                float bv = kf(-3.0e38f); int bi = 0;
                for (int e = 0; e < 32; ++e) { const float v = lg[row * 33 + e]; if (!((used >> e) & 1u) && v > bv) { bv = v; bi = e; } }
                used |= 1u << bi; idx[k] = bi; val[k] = bv;
            }
            float ex[4], sm = 0.f;
#pragma unroll
            for (int k = 0; k < 4; ++k) { ex[k] = fexp(val[k] - val[0]); sm += ex[k]; }
#pragma unroll
            for (int k = 0; k < 4; ++k) {
                const int slot = row * 4 + k;
                se[slot] = idx[k]; sg[slot] = ex[k] / sm; sr[slot] = __hip_atomic_fetch_add(&lc[idx[k]], 1, __ATOMIC_RELAXED, __HIP_MEMORY_SCOPE_WORKGROUP);
            }
        }
        __syncthreads();
        if (tid < 32) base[tid] = atomicAdd(&cnt_l[tid], lc[tid]);
        __syncthreads();
        if (tid < 256) {
            const int e = se[tid], rank = base[e] + sr[tid], t = tok0 + (tid >> 2);
            LTOK[(size_t)e * T + rank] = t; LGATE[(size_t)e * T + rank] = sg[tid]; PE[t * 4 + (tid & 3)] = e; PR[t * 4 + (tid & 3)] = rank;
        }
    }
}
}

__device__ __forceinline__ void combine_phase(LAS unsigned char* lds, const bf16_t* X, bf16_t* Xo, const unsigned char* __restrict__ YB, const float* __restrict__ mod_l, const int* __restrict__ cnt_l,
                                              const int* __restrict__ PE, const int* __restrict__ PR, const float* __restrict__ gain, const float* __restrict__ mod_n,
                                              bf16_t* __restrict__ H1B, float* __restrict__ out, int G, int c) {
    const int tid = tid_hidden(), wid = tid >> 6, lane = tid & 63;
    LAS int* offp = (LAS int*)lds;
    __syncthreads();
    if (tid == 0) { int run = 0; for (int e = 0; e < NE; ++e) { offp[e] = run; run += ((cnt_l[e] + 255) >> 8) << 8; } }
    __syncthreads();
    for (int blk = c; blk < T / 64; blk += G) {
        const int t0 = blk * 64 + wid * 8, b = t0 / SEQ, k0 = lane * 16;
        f32x4 g2[4], gn[4], sh[4];
#pragma unroll
        for (int q = 0; q < 4; ++q) {
            g2[q] = *(const f32x4*)(mod_l + (size_t)b * 6 * D + 5 * D + k0 + 4 * q) * (1.f / Y8_SCALE);
            const f32x4 g = *(const f32x4*)(gain + k0 + 4 * q);
            if (mod_n) { const f32x4 sc = *(const f32x4*)(mod_n + (size_t)b * 6 * D + D + k0 + 4 * q); sh[q] = *(const f32x4*)(mod_n + (size_t)b * 6 * D + k0 + 4 * q); gn[q] = g * (sc + 1.f); }
            else { gn[q] = g; sh[q] = (f32x4){0.f, 0.f, 0.f, 0.f}; }
        }
        int rowv = 0;
        if (lane < 32) { const int e = PE[t0 * 4 + lane], rk = PR[t0 * 4 + lane]; rowv = offp[e] + rk; }
#pragma unroll 2
        for (int i = 0; i < 8; ++i) {
            const int t = t0 + i;
            u32x4 yv[4];
#pragma unroll
            for (int k = 0; k < 4; ++k) { const int row = __builtin_amdgcn_readlane(rowv, i * 4 + k); yv[k] = *(const u32x4*)(YB + (size_t)row * D + k0); }
            const u32x4 x0 = *(const u32x4*)(X + (size_t)t * D + k0), x1 = *(const u32x4*)(X + (size_t)t * D + k0 + 8);
            f32x4 v[4]; float ss = 0.f;
#pragma unroll
            for (int q = 0; q < 4; ++q) {
                f32x4 a = (f32x4){0.f, 0.f, 0.f, 0.f};
#pragma unroll
                for (int k = 0; k < 4; ++k) { const unsigned w = q == 0 ? yv[k].x : q == 1 ? yv[k].y : q == 2 ? yv[k].z : yv[k].w;
                    const f32x2_t lo = __builtin_amdgcn_cvt_pk_f32_fp8((int)w, false), hi = __builtin_amdgcn_cvt_pk_f32_fp8((int)w, true);
                    a[0] += lo.x; a[1] += lo.y; a[2] += hi.x; a[3] += hi.y; }
                const u32x4 xq = (q >> 1) ? x1 : x0; const unsigned xa = (q & 1) ? xq.z : xq.x, xb = (q & 1) ? xq.w : xq.y;
                v[q] = (f32x4){__uint_as_float(xa << 16), __uint_as_float(xa & 0xffff0000u), __uint_as_float(xb << 16), __uint_as_float(xb & 0xffff0000u)} + g2[q] * a;
                ss += v[q][0] * v[q][0] + v[q][1] * v[q][1] + v[q][2] * v[q][2] + v[q][3] * v[q][3];
            }
            for (int of = 32; of > 0; of >>= 1) ss += shx(ss, of);
            const float r = rsqrtf(ss * (1.f / D) + kf(EPS));
            if (mod_n) {
                u32x4 xo0, xo1, h0, h1;
                xo0.x = cvt_pk_bf16(v[0][0], v[0][1]); xo0.y = cvt_pk_bf16(v[0][2], v[0][3]); xo0.z = cvt_pk_bf16(v[1][0], v[1][1]); xo0.w = cvt_pk_bf16(v[1][2], v[1][3]);
                xo1.x = cvt_pk_bf16(v[2][0], v[2][1]); xo1.y = cvt_pk_bf16(v[2][2], v[2][3]); xo1.z = cvt_pk_bf16(v[3][0], v[3][1]); xo1.w = cvt_pk_bf16(v[3][2], v[3][3]);
                *(u32x4*)(Xo + (size_t)t * D + k0) = xo0; *(u32x4*)(Xo + (size_t)t * D + k0 + 8) = xo1;
                f32x4 o[4];
#pragma unroll
                for (int q = 0; q < 4; ++q) o[q] = v[q] * r * gn[q] + sh[q];
                h0.x = cvt_pk_bf16(o[0][0], o[0][1]); h0.y = cvt_pk_bf16(o[0][2], o[0][3]); h0.z = cvt_pk_bf16(o[1][0], o[1][1]); h0.w = cvt_pk_bf16(o[1][2], o[1][3]);
                h1.x = cvt_pk_bf16(o[2][0], o[2][1]); h1.y = cvt_pk_bf16(o[2][2], o[2][3]); h1.z = cvt_pk_bf16(o[3][0], o[3][1]); h1.w = cvt_pk_bf16(o[3][2], o[3][3]);
                *(u32x4*)(H1B + (size_t)t * D + k0) = h0; *(u32x4*)(H1B + (size_t)t * D + k0 + 8) = h1;
            } else {
#pragma unroll
                for (int q = 0; q < 4; ++q) *(f32x4*)(out + (size_t)t * D + k0 + 4 * q) = v[q] * r * gn[q];
            }
        }
    }
}

#ifndef PROBE
#endif
constexpr int N_PHASES = 2 + 9 * DEPTH;
__global__ void __launch_bounds__(512, 2) fwd(Args a) {
    extern __shared__ __attribute__((aligned(16))) unsigned char lds_raw[];
    LAS unsigned char* lds0 = (LAS unsigned char*)lds_raw;
#define GGX sgpr_hidden((int)gridDim.x)
#define CCX sgpr_hidden((int)blockIdx.x)
#define lds lds_hidden(lds0)
    if (threadIdx.x == 0) { ((LAS unsigned*)(lds0 + LDS_BAR_OFF))[0] = 0u; ((LAS unsigned*)(lds0 + LDS_BAR_OFF))[1] = 0u; }
    __syncthreads();
    (void)xcd_barrier_post((unsigned*)(unsigned GAS*)(args_hidden()->ws), (volatile LAS unsigned*)(lds0 + LDS_BAR_OFF));
    const int lo = ARG(ph_lo), hi = ARG(ph_hi);
#define IN(k) (lo <= (k) && (k) < hi)
#define FORCE_BAR() do { XcdBarrier bar_; bar_.bar = (unsigned*)(unsigned GAS*)ptr_hidden(args_hidden()->ws); bar_.x = xb_xcc_id(); bar_.st = (volatile LAS unsigned*)(lds + LDS_BAR_OFF); xcd_barrier(bar_); } while (0)
#if PROBE == 4
#define SEAM(k) do { if (IN(k) && IN((k) + 1)) { FORCE_BAR(); FORCE_BAR(); FORCE_BAR(); } } while (0)
#else
#define SEAM(k) do { if (IN(k) && IN((k) + 1)) { XcdBarrier bar_; bar_.bar = (unsigned*)(unsigned GAS*)ptr_hidden(args_hidden()->ws); bar_.x = xb_xcc_id(); bar_.st = (volatile LAS unsigned*)(lds + LDS_BAR_OFF); xcd_barrier(bar_); } } while (0)
#endif
#define WSP(type, off) ((type*)(type GAS*)ptr_hidden(args_hidden()->ws + (off)))
#define X WSP(bf16_t, W_X)
#define H1B WSP(bf16_t, W_H1B)
#define MIXB WSP(bf16_t, W_MIXB)
#define H2B WSP(bf16_t, W_H2B)
#define QA WSP(bf16_t, W_QA)
#define KA WSP(bf16_t, W_KA)
#define VTA WSP(bf16_t, W_VTA)
#define QH WSP(bf16_t, W_QH)
#define LF WSP(bf16_t, W_LF)
#define VTH WSP(bf16_t, W_VTH)
#define GS WSP(bf16_t, W_GS)
#define AO WSP(bf16_t, W_AO)
#define SSQ WSP(float, W_SSQ)
#define UT WSP(bf16_t, W_UT)
#define SIN WSP(bf16_t, W_SIN)
#define DEC WSP(float, W_DEC)
#define MOD WSP(float, W_MOD)
#define LOW WSP(float, W_LOW)
#define ROPE WSP(float, W_ROPE)
#define WRP WSP(float, W_WRP)
#define BRP WSP(float, W_BRP)
#define LTOK WSP(int, W_LTOK)
#define LGATE WSP(float, W_LGATE)
#define PE WSP(int, W_PE)
#define PR WSP(int, W_PR)
#define ACTB WSP(bf16_t, W_ACTB)
#define YB WSP(unsigned char, W_YB)
#define WINT WSP(bf16_t, W_WINT)
#define WOUTT WSP(bf16_t, W_WOUTT)
#define WGUT WSP(bf16_t, W_WGUT)
#define WDT WSP(bf16_t, W_WDT)
#define CNT WSP(int, W_CNT)
    if (IN(0)) { ada_phase(lds, ARGP(c), ARGP(w_ada), ARGP(b_ada), MOD, GGX, CCX); misc_phase(ARGP(lbl), ARGP(pos), LOW, ROPE, GGX, CCX); conv_phase(lds, ARGP(w_in), ARGP(w_out), ARGP(w_gu), ARGP(w_down), (unsigned char*)ptr_hidden(args_hidden()->ws), GGX, CCX); }
    SEAM(0);
    if (IN(1)) { wrp_phase(ARGP(norm2), ARGP(w_router), ARGP(b_router), (unsigned char*)ptr_hidden(args_hidden()->ws), GGX, CCX); norm_phase(ARGP(x), ARGP(norm1), MOD, 0, D, H1B, X, GGX, CCX); }
    SEAM(1);
#if PROBE == 1
    if (IN(0)) { ada_phase(lds, ARGP(c), ARGP(w_ada), ARGP(b_ada), MOD, GGX, CCX); misc_phase(ARGP(lbl), ARGP(pos), LOW, ROPE, GGX, CCX); conv_phase(lds, ARGP(w_in), ARGP(w_out), ARGP(w_gu), ARGP(w_down), (unsigned char*)ptr_hidden(args_hidden()->ws), GGX, CCX); }
    FORCE_BAR();
    if (IN(1)) { wrp_phase(ARGP(norm2), ARGP(w_router), ARGP(b_router), (unsigned char*)ptr_hidden(args_hidden()->ws), GGX, CCX); norm_phase(ARGP(x), ARGP(norm1), MOD, 0, D, H1B, X, GGX, CCX); }
    FORCE_BAR();
#endif
#pragma unroll 1
    for (int l = 0; l < DEPTH; ++l) {
        const int p0 = 2 + 9 * l;
#define mod_l (MOD + (size_t)l * NB * 6 * D)
#define cnt_l (CNT + l * NE)
        if (IN(p0 + 0)) {
            g8::DenseSrc S; S.init(H1B, WINT + (size_t)l * INW * 1024, 0, GGX == 256 ? 12 : 13, GGX, CCX);
            g8::EpiProj E{QA, KA, VTA, QH, LF, VTH, GS, ROPE, LOW + (size_t)l * 1024};
            g8::gemm_phase(lds, S, E);
        }
#if PROBE == 5
        if (IN(p0 + 0)) { FORCE_BAR();
            g8::DenseSrc S; S.init(H1B, WINT + (size_t)l * INW * 1024, 0, GGX == 256 ? 12 : 13, GGX, CCX);
            g8::EpiProj E{QA, KA, VTA, QH, LF, VTH, GS, ROPE, LOW + (size_t)l * 1024};
            g8::gemm_phase(lds, S, E);
        }
#endif
        SEAM(p0 + 0);
        if (IN(p0 + 1)) {
            const int g_ = GGX, c_ = CCX;
            if (g_ == 256) {
                { g8::DenseSrc S; S.init(H1B, WINT + (size_t)l * INW * 1024, 12, 1, g_, c_);
                  g8::EpiProj E{QA, KA, VTA, QH, LF, VTH, GS, ROPE, LOW + (size_t)l * 1024};
                  g8::gemm_phase(lds, S, E); }
                const int af = c_ < 64 ? 0 : (c_ < 128 ? (c_ - 64) * 2 : 128 + (c_ - 128)), an = c_ < 64 ? 0 : (c_ < 128 ? 2 : 1);
                const int cf = c_ < 64 ? c_ * 5 : (c_ < 128 ? 320 + (c_ - 64) : 384 + (c_ - 128) * 5), cn = c_ < 64 ? 5 : (c_ < 128 ? 1 : 5);
                att::attn_phase(lds, QA, KA, VTA, ARGP(sink) + l * 8, AO, SSQ, af, an, 1);
#if PROBE == 8
                att::attn_phase(lds, QA, KA, VTA, ARGP(sink) + l * 8, AO, SSQ, af, an, 1);
#endif
                hg::c1_phase(lds, LF, VTH, UT, DEC, cf, cn, 1);
#if PROBE == 9
                hg::c1_phase(lds, LF, VTH, UT, DEC, cf, cn, 1);
#endif
            } else {
                att::attn_phase(lds, QA, KA, VTA, ARGP(sink) + l * 8, AO, SSQ, c_, (NB * 32 - c_ + g_ - 1) / g_, g_);
                hg::c1_phase(lds, LF, VTH, UT, DEC, c_, (NB * 128 - c_ + g_ - 1) / g_, g_);
            }
        }
        SEAM(p0 + 1);
        if (IN(p0 + 2)) hg::c2_phase(UT, DEC, SIN, GGX, CCX);
#if PROBE == 10
        if (IN(p0 + 2)) hg::c2_phase(UT, DEC, SIN, GGX, CCX);
#endif
        SEAM(p0 + 2);
        if (IN(p0 + 3)) hg::c3_phase(lds, QH, LF, VTH, SIN, GS, ARGP(hg_norm) + l * 128, AO, SSQ, ARGP(attn_norm) + l * 512, MIXB, GGX, CCX);
#if PROBE == 11
        if (IN(p0 + 3)) hg::c3_phase(lds, QH, LF, VTH, SIN, GS, ARGP(hg_norm) + l * 128, AO, SSQ, ARGP(attn_norm) + l * 512, MIXB, GGX, CCX);
#endif
        SEAM(p0 + 3);
        if (IN(p0 + 4)) {
            g8::DenseSrc S; S.init(MIXB, WOUTT + (size_t)l * D * 1024, 0, D / 256, GGX, CCX);
            g8::EpiOutRes E{X, mod_l + 2 * D};
            g8::gemm_phase(lds, S, E);
        }
        SEAM(p0 + 4);
#if PROBE == 6
        if (IN(p0 + 5)) { rt::router_phase(lds, X, ARGP(norm2) + l * D, mod_l, WRP + (size_t)l * NB * D * NE, BRP + (size_t)l * NB * NE, MIXB, CNT + 128 + l * NE, (int*)ACTB, (float*)YB, (int*)UT, (int*)SIN, GGX, CCX); FORCE_BAR(); }
#endif
        if (IN(p0 + 5)) rt::router_phase(lds, X, ARGP(norm2) + l * D, mod_l, (const bf16_t*)WRP + (size_t)l * NB * D * NE, (const bf16_t*)WRP + (size_t)(DEPTH + l) * NB * D * NE, BRP + (size_t)l * NB * NE, H2B, cnt_l, LTOK, LGATE, PE, PR, GGX, CCX);
        SEAM(p0 + 5);
        if (IN(p0 + 6)) {
            g8::MoeSrc<true, 8, true> S; S.init(lds, H2B, LTOK, (const bf16_t*)((const unsigned char*)WGUT + (size_t)l * NE * 2048 * 1024), cnt_l, GGX, CCX); S.done = WSP(unsigned, W_DONE) + l * 512;
            g8::EpiGU E{(unsigned char*)ACTB, ARGP(b_gu) + (size_t)l * NE * 2048};
            g8::gemm_phase(lds, S, E);
        }
        if (IN(p0 + 6)) {
            g8::MoeSrc<false, 4, true, true, true> S; S.init(lds, ACTB, nullptr, (const bf16_t*)((const unsigned char*)WDT + (size_t)l * NE * 1024 * 1024), cnt_l, GGX, CCX); S.done = WSP(unsigned, W_DONE) + l * 512;
            g8::EpiDown E{YB, ARGP(b_down) + (size_t)l * NE * D, LGATE};
            g8::gemm_phase(lds, S, E);
        }
        SEAM(p0 + 7);
#if PROBE == 3
        if (IN(p0 + 6)) {
            g8::MoeSrc<true, 8, true> S; S.init(lds, H2B, LTOK, (const bf16_t*)((const unsigned char*)WGUT + (size_t)l * NE * 2048 * 1024), cnt_l, GGX, CCX);
            g8::EpiGU E{(unsigned char*)ACTB, ARGP(b_gu) + (size_t)l * NE * 2048};
            g8::gemm_phase(lds, S, E);
        }
        FORCE_BAR();
        if (IN(p0 + 7)) {
            g8::MoeSrc<false, 4, true> S; S.init(lds, ACTB, nullptr, (const bf16_t*)((const unsigned char*)WDT + (size_t)l * NE * 1024 * 1024), cnt_l, GGX, CCX);
            g8::EpiDown E{YB, ARGP(b_down) + (size_t)l * NE * D, LGATE};
            g8::gemm_phase(lds, S, E);
        }
        FORCE_BAR();
#endif
#if PROBE == 7
        if (IN(p0 + 8)) { combine_phase(lds, X, (float*)SIN, YB, mod_l, cnt_l, PE, PR, ARGP(norm1) + l * D, mod_l, MIXB, (float*)SIN, GGX, CCX); FORCE_BAR(); }
#endif
        if (IN(p0 + 8)) {
            const bool lastl = (l == DEPTH - 1);
            combine_phase(lds, X, X, YB, mod_l, cnt_l, PE, PR, lastl ? ARGP(final_norm) : ARGP(norm1) + (l + 1) * D, lastl ? nullptr : mod_l + NB * 6 * D, H1B, ARGP(out), GGX, CCX);
        }
        if (l + 1 < DEPTH) SEAM(p0 + 8);
    }
#undef GGX
#undef CCX
#undef lds
#undef IN
#undef SEAM
#undef FORCE_BAR
}
}

#ifndef N_LAUNCH_SPLIT
#define N_LAUNCH_SPLIT 0
#endif
extern "C" void kernel_launch(void* const* d_in, const int* in_sizes, int n_in, void* d_out, int out_size, void* d_ws, size_t ws_size, hipStream_t stream) {
    static int grid = 0;
    if (grid == 0) {
        int dev = 0, cus = 0;
        if (hipGetDevice(&dev) != hipSuccess || hipDeviceGetAttribute(&cus, hipDeviceAttributeMultiprocessorCount, dev) != hipSuccess || cus <= 0) cus = 256;
        (void)hipFuncSetAttribute((const void*)fwd, hipFuncAttributeMaxDynamicSharedMemorySize, g8::LDS_TOTAL);
        int per_cu = 0;
        (void)hipOccupancyMaxActiveBlocksPerMultiprocessor(&per_cu, (const void*)fwd, 512, g8::LDS_TOTAL);
        (void)hipGetLastError();
        grid = cus;
    }
    (void)hipMemsetAsync(d_ws, 0, CTL_BYTES, stream);
    Args a{};
    a.x = (const float*)d_in[0]; a.c = (const float*)d_in[1]; a.pos = (const int*)d_in[2]; a.w_ada = (const float*)d_in[3]; a.b_ada = (const float*)d_in[4];
    a.norm1 = (const float*)d_in[5]; a.w_in = (const float*)d_in[6]; a.sink = (const float*)d_in[7]; a.attn_norm = (const float*)d_in[8]; a.lbl = (const float*)d_in[9];
    a.hg_norm = (const float*)d_in[10]; a.w_out = (const float*)d_in[11]; a.norm2 = (const float*)d_in[12]; a.w_router = (const float*)d_in[13]; a.b_router = (const float*)d_in[14];
    a.w_gu = (const float*)d_in[15]; a.b_gu = (const float*)d_in[16]; a.w_down = (const float*)d_in[17]; a.b_down = (const float*)d_in[18]; a.final_norm = (const float*)d_in[19];
    a.out = (float*)d_out; a.ws = (unsigned char*)d_ws;
#if N_LAUNCH_SPLIT
    for (int p = 0; p < N_PHASES; ++p) { a.ph_lo = p; a.ph_hi = p + 1; hipLaunchKernelGGL(fwd, dim3(grid), dim3(512), g8::LDS_TOTAL, stream, a); }
#else
    a.ph_lo = 0; a.ph_hi = N_PHASES;
    hipLaunchKernelGGL(fwd, dim3(grid), dim3(512), g8::LDS_TOTAL, stream, a);
#endif
}
```

```cpp
#include <hip/hip_runtime.h>
#include <stdint.h>

namespace {
constexpr int D = 1024, NB = 8, SEQ = 2048, T = NB * SEQ, DEPTH = 4;
constexpr int INW = 3328, NE = 32, TOPK = 4, DFF = 1024, NP = T * TOPK;
constexpr int C_QA = 0, C_KA = 512, C_VA = 640, C_QH = 768, C_FF = 1280, C_FB = 1792, C_IH = 2304, C_GH = 2816;
constexpr float EPS = 1e-6f;
#define LAS __attribute__((address_space(3)))
typedef unsigned short bf16_t;
typedef short bf16x8 __attribute__((ext_vector_type(8)));
typedef float f32x4 __attribute__((ext_vector_type(4)));
typedef unsigned u32x2 __attribute__((ext_vector_type(2)));
typedef unsigned u32x4 __attribute__((ext_vector_type(4)));
typedef int i32x8 __attribute__((ext_vector_type(8)));
typedef short s16x16a __attribute__((ext_vector_type(16), aligned(16)));
typedef float f32x2_t __attribute__((ext_vector_type(2)));
typedef __bf16 bf16x2_t __attribute__((ext_vector_type(2)));
__device__ __forceinline__ unsigned cvt_pk_bf16(float lo, float hi) { const bf16x2_t r = __builtin_convertvector((f32x2_t){lo, hi}, bf16x2_t); return __builtin_bit_cast(unsigned, r); }
__device__ __forceinline__ unsigned cvt_pk4_fp8(float a, float b, float c, float d) { int w = 0; w = __builtin_amdgcn_cvt_pk_fp8_f32(a, b, w, false); w = __builtin_amdgcn_cvt_pk_fp8_f32(c, d, w, true); return (unsigned)w; }
constexpr float MX_SCALE = 1.f;
constexpr float W8_SCALE = 64.f, ACT8_SCALE = 4.f, H28_SCALE = 8.f, Y8_SCALE = 16.f;
__device__ __forceinline__ bf16_t f2bf(float f) { unsigned u = __float_as_uint(f); u += 0x7FFFu + ((u >> 16) & 1u); return (bf16_t)(u >> 16); }
__device__ __forceinline__ float bf2f(bf16_t b) { return __uint_as_float(((unsigned)b) << 16); }
__device__ __forceinline__ int tid_hidden() { int t = threadIdx.x; asm volatile("" : "+v"(t)); return t; }
#define GAS __attribute__((address_space(1)))
__device__ __forceinline__ float fexp(float x) { return __builtin_amdgcn_exp2f(x * 1.4426950408889634f); }
__device__ __forceinline__ float flog(float x) { return __builtin_amdgcn_logf(x) * 0.6931471805599453f; }
__device__ __forceinline__ float kf(float x) { asm volatile("" : "+s"(x)); return x; }
__device__ __forceinline__ float shx(float v, int m) { int ln; asm volatile("v_mbcnt_lo_u32_b32 %0, -1, 0\n\tv_mbcnt_hi_u32_b32 %0, -1, %0" : "=v"(ln)); return __builtin_bit_cast(float, __builtin_amdgcn_ds_bpermute((ln ^ m) << 2, __builtin_bit_cast(int, v))); }
__device__ __forceinline__ GAS unsigned char* ptr_hidden(GAS unsigned char* p) { asm volatile("" : "+s"(p)); return p; }
__device__ __forceinline__ int sgpr_hidden(int v) { asm volatile("" : "+s"(v)); return v; }
__device__ __forceinline__ LAS unsigned char* lds_hidden(LAS unsigned char* p) { asm volatile("" : "+s"(p)); return p; }
__device__ __forceinline__ unsigned xb_ld(unsigned* p)              { unsigned GAS* g = (unsigned GAS*)p; asm volatile("" : "+s"(g)); return __hip_atomic_load(g, __ATOMIC_RELAXED, __HIP_MEMORY_SCOPE_AGENT); }
__device__ __forceinline__ unsigned xb_add(unsigned* p, unsigned v) { unsigned GAS* g = (unsigned GAS*)p; asm volatile("" : "+s"(g)); return __hip_atomic_fetch_add(g, v, __ATOMIC_RELAXED, __HIP_MEMORY_SCOPE_AGENT); }
#define PROBE 0
namespace g8 {
constexpr int BM = 256, BK = 64, HALF = 128, HTB = HALF * BK * 2, STAGE_BYTES = 8 * HTB, KD = 1024, NKT = KD / BK;
constexpr int TAB_OFF = STAGE_BYTES;
constexpr int LDS_TOTAL = 147456;
__device__ __forceinline__ int lds_byte(int r, int c) { const int st = (r >> 4) * 2 + (c >> 5), rr = r & 15, cc = c & 31, ob = rr * 64 + cc * 2; return st * 1024 + (ob ^ (((ob >> 9) & 1) << 5)); }
__device__ __forceinline__ void stage_rc(int b, int& R, int& C) { const int st = b / 1024, sb = b % 1024, swz = sb ^ (((sb >> 9) & 1) << 5); R = (st >> 1) * 16 + swz / 64; C = (st & 1) * 32 + (swz % 64) / 2; }
__host__ __device__ __forceinline__ int perm32(int rho) { const int n = rho >> 4, i = rho & 15; return 8 * (i >> 2) + 4 * n + (i & 3); }

struct Unit { int e, rt, pn, cnt, rowbase; };

constexpr int PRE_OFF = TAB_OFF + 2048;
constexpr int EPI_OFF = PRE_OFF + 512;
constexpr int ULIST_OFF = EPI_OFF + 4096;
template <bool GATHER_, int NTN, bool FP8_, bool WAITS_ = false, bool REV_ = false>
struct MoeSrc {
    static constexpr bool GATHER = GATHER_, FP8 = FP8_, WAITS = WAITS_;
    unsigned* done;
    __device__ __forceinline__ int tile_of(int i) const { return (lo + rk + i * nw) / NTN; }
    __device__ __forceinline__ void publish(int i) const { if (threadIdx.x == 0) (void)xb_add(done + tile_of(i), 1u); }
    __device__ __forceinline__ void wait_tile(int i) const {
        if (threadIdx.x == 0) { unsigned* w = done + tile_of(i); unsigned sp = 0u;
            while (xb_ld(w) < 8u) { __builtin_amdgcn_s_sleep(1); if (++sp > (1u << 16)) break; } }
    }
    static constexpr int RB = FP8_ ? KD : KD * 2;
    const bf16_t* A; const int* ltok; const bf16_t* Bt; LAS const int* tb;
    int nw, rk, lo, hi;
    __device__ __forceinline__ void init(LAS unsigned char* lds, const bf16_t* A_, const int* ltok_, const bf16_t* Bt_, const int* cnt, int G, int c) {
        A = A_; ltok = ltok_; Bt = Bt_;
        LAS int* t = (LAS int*)(lds + PRE_OFF); tb = t;
        __syncthreads();
        const int tidi = tid_hidden();
        if (tidi == 0) { int run = 0, ro = 0; for (int e = 0; e < NE; ++e) { const int ce = cnt[e]; t[e] = run; t[33 + e] = ro; t[66 + e] = ce; run += ((ce + 255) >> 8) * NTN; ro += ((ce + 255) >> 8) << 8;   } t[32] = run; t[65] = ro; }
        __syncthreads();
        const int U = __builtin_amdgcn_readfirstlane(t[32]), xg = c & 7;
        nw = (G + 7 - xg) >> 3; rk = REV_ ? nw - 1 - (c >> 3) : (c >> 3);
        lo = (int)(((long)xg * U) >> 3); hi = (int)(((long)(xg + 1) * U) >> 3);
        if (tidi < 16) { Unit u; const bool ok = next_slow<false>(tidi, u); LAS int* r = t + (ULIST_OFF - PRE_OFF) / 4 + tidi * 8;
            r[0] = ok ? u.e : -1; r[1] = u.rt; r[2] = u.pn; r[3] = u.cnt; r[4] = u.rowbase; }
        __syncthreads();
    }
    template <bool UNI>
    __device__ __forceinline__ bool next_slow(int i, Unit& u) const {
        const int g = lo + rk + i * nw; if (g >= hi) return false;
        int e = 0;
#pragma unroll
        for (int st = 16; st > 0; st >>= 1) { const int v = UNI ? __builtin_amdgcn_readfirstlane(tb[e + st]) : tb[e + st]; if (v <= g) e += st; }
        const int p = tb[e], cn = tb[66 + e], ro = tb[33 + e];
        const int loc = g - (UNI ? __builtin_amdgcn_readfirstlane(p) : p);
        u.e = e; u.rt = loc / NTN; u.pn = loc % NTN; u.cnt = UNI ? __builtin_amdgcn_readfirstlane(cn) : cn; u.rowbase = UNI ? __builtin_amdgcn_readfirstlane(ro) : ro;
        return true;
    }
    __device__ __forceinline__ bool next(int i, Unit& u) const {
        if (i < 16) {
            LAS const int* r = tb + (ULIST_OFF - PRE_OFF) / 4 + i * 8;
            const int e = __builtin_amdgcn_readfirstlane(r[0]);
            if (e < 0) return false;
            u.e = e; u.rt = __builtin_amdgcn_readfirstlane(r[1]); u.pn = __builtin_amdgcn_readfirstlane(r[2]); u.cnt = __builtin_amdgcn_readfirstlane(r[3]); u.rowbase = __builtin_amdgcn_readfirstlane(r[4]);
            return true;
        }
        return next_slow<true>(i, u);
    }
    __device__ __forceinline__ const char* bptr(const Unit& u) const { return (const char*)Bt + ((size_t)u.e * NTN * BM + (size_t)u.pn * BM) * RB; }
};

typedef short s16x16 __attribute__((ext_vector_type(16)));
__device__ __forceinline__ i32x8 frag8(bf16x8 lo, bf16x8 hi) { return __builtin_bit_cast(i32x8, __builtin_shufflevector(lo, hi, 0, 1, 2, 3, 4, 5, 6, 7, 8, 9, 10, 11, 12, 13, 14, 15)); }
template <class Src>
__device__ __forceinline__ void tab_fill(const Src& S, const Unit& u, int tid, int wid, LAS unsigned char* lds, int par) {
    if (Src::GATHER && wid < 4) {
        int rr = u.rt * BM + tid; rr = rr < u.cnt ? rr : u.cnt - 1;
        __builtin_amdgcn_global_load_lds((const unsigned*)(S.ltok + (size_t)u.e * T + rr), (LAS unsigned*)(lds + TAB_OFF + par * 1024 + wid * 256), 4, 0, 0);
    }
}

template <class Epi, class Src>
__device__ __forceinline__ void gemm_phase(LAS unsigned char* lds, const Src S, const Epi E) {
    const int tid = tid_hidden(), wid = __builtin_amdgcn_readfirstlane(tid >> 6), lane = tid & 63, wr = wid >> 2, wc = wid & 3, fr = lane & 15, fq = lane >> 4;
    int R0, C0; stage_rc(tid * 16, R0, C0);
    constexpr int RB = Src::RB, NKTR = RB / 128;
    const unsigned vo0 = (unsigned)(R0 * RB + C0 * 2);
    const unsigned tabA = (unsigned)R0 * 4u, colB = (unsigned)C0 * 2u;
    const size_t kstep = (size_t)(BK * 2);
    const size_t hstep = (size_t)HALF * RB;
    const unsigned ldsw = (unsigned)wid * 1024u;
    const int aoff = lds_byte(wr * 64 + fr, fq * 8);
    const int boff = lds_byte(wc * 32 + fr, fq * 8);
#define G8_SA(b, h) (((b) * 2 + (h)) * HTB)
#define G8_SB(b, h) ((4 + (b) * 2 + (h)) * HTB)
#define G8_GLDS(gp, bufoff, i) __builtin_amdgcn_global_load_lds((const unsigned*)(gp), (LAS unsigned*)(lds + (bufoff) + ldsw + (i) * 8192), 16, 0, 0)
#define G8_STAGE_U(bufoff, gbase) do { const char* _g = (const char*)(gbase); const char* _g1 = _g + (size_t)(64 * RB); asm volatile("" : "+s"(_g), "+s"(_g1));   \
        G8_GLDS(_g + vo0, bufoff, 0); G8_GLDS(_g1 + vo0, bufoff, 1); } while (0)
    unsigned tv0 = 0u, tv1 = 0u;
#define G8_TABRD(par, h) do { if constexpr (Src::GATHER) { LAS const int* _t = (LAS const int*)(lds + TAB_OFF + (par) * 1024 + (h) * 512 + tabA); tv0 = (unsigned)_t[0]; tv1 = (unsigned)_t[64]; } } while (0)
#define G8_STAGE_G(bufoff, kb) do { const char* _gb = Ab + (kb); G8_GLDS(_gb + (tv0 * (unsigned)RB + colB), bufoff, 0); G8_GLDS(_gb + (tv1 * (unsigned)RB + colB), bufoff, 1); } while (0)
#define G8_STAGE_A(bufoff, up, par, h, kb) do { if constexpr (Src::GATHER) G8_STAGE_G(bufoff, kb); else G8_STAGE_U(bufoff, (up) + (h) * hstep + (kb)); } while (0)
#define G8_LDA(dst, b, h) do { if constexpr (Src::FP8) { _Pragma("unroll") for (int m = 0; m < 4; ++m) dst##8[m] = frag8(*(const LAS bf16x8*)(lds + G8_SA(b, h) + aoff + m * 2048), *(const LAS bf16x8*)(lds + G8_SA(b, h) + aoff + m * 2048 + 1024)); } \
        else { _Pragma("unroll") for (int m = 0; m < 4; ++m) _Pragma("unroll") for (int k = 0; k < 2; ++k) dst[m][k] = *(const LAS bf16x8*)(lds + G8_SA(b, h) + aoff + m * 2048 + k * 1024); } } while (0)
#define G8_LDB(dst, b, h) do { if constexpr (Src::FP8) { _Pragma("unroll") for (int n = 0; n < 2; ++n) dst##8[n] = frag8(*(const LAS bf16x8*)(lds + G8_SB(b, h) + boff + n * 2048), *(const LAS bf16x8*)(lds + G8_SB(b, h) + boff + n * 2048 + 1024)); } \
        else { _Pragma("unroll") for (int n = 0; n < 2; ++n) _Pragma("unroll") for (int k = 0; k < 2; ++k) dst[n][k] = *(const LAS bf16x8*)(lds + G8_SB(b, h) + boff + n * 2048 + k * 1024); } } while (0)
#define G8_MMA(ai, bj, At, Bt) do { __builtin_amdgcn_s_setprio(1); _Pragma("unroll") for (int m = 0; m < 4; ++m) _Pragma("unroll") for (int n = 0; n < 2; ++n) { \
        if constexpr (Src::FP8) acc[ai][bj][m][n] = __builtin_amdgcn_mfma_scale_f32_16x16x128_f8f6f4(Bt##8[n], At##8[m], acc[ai][bj][m][n], 0, 0, 0, mxs, 0, mxs); \
        else { _Pragma("unroll") for (int k = 0; k < 2; ++k) acc[ai][bj][m][n] = __builtin_amdgcn_mfma_f32_16x16x32_bf16(Bt[n][k], At[m][k], acc[ai][bj][m][n], 0, 0, 0); } } \
        __builtin_amdgcn_s_setprio(0); } while (0)
#define G8_WAIT_V(n) asm volatile("s_waitcnt vmcnt(" #n ")" ::: "memory")
#define G8_WAIT_L(n) asm volatile("s_waitcnt lgkmcnt(" #n ")" ::: "memory")
#define G8_BAR __builtin_amdgcn_s_barrier()
#define G8_SCHED __builtin_amdgcn_sched_barrier(0)
    Unit cur, nxt; int ui = 0;
    if (!S.next(0, cur)) return;
    if constexpr (Src::WAITS) { S.wait_tile(0); __syncthreads(); }
    f32x4 acc[2][2][4][2];
#pragma unroll
    for (int a = 0; a < 2; ++a)
#pragma unroll
        for (int b = 0; b < 2; ++b)
#pragma unroll
            for (int m = 0; m < 4; ++m)
#pragma unroll
                for (int n = 0; n < 2; ++n) acc[a][b][m][n] = (f32x4){0.f, 0.f, 0.f, 0.f};
    bf16x8 At[4][2], B0[2][2], B1[2][2];
    i32x8 At8[4], B08[2], B18[2];
    int mxs = 0x7f7f7f7f; asm volatile("" : "+v"(mxs));
    const char* Ab = (const char*)S.A;
    const char* cB = S.bptr(cur);
    const char* cA = Ab + (size_t)(cur.rowbase + cur.rt * BM) * RB;
    int par = 0;
    if (Src::GATHER) { tab_fill(S, cur, tid, wid, lds, 0); G8_WAIT_V(0); __syncthreads(); }
    G8_STAGE_U(G8_SB(0, 0), cB); G8_TABRD(0, 0); G8_STAGE_A(G8_SA(0, 0), cA, 0, 0, 0); G8_STAGE_U(G8_SB(0, 1), cB + hstep); G8_TABRD(0, 1); G8_STAGE_A(G8_SA(0, 1), cA, 0, 1, 0);
    if (wr == 1) G8_BAR;
    G8_WAIT_V(4); G8_BAR;
    G8_STAGE_U(G8_SB(1, 0), cB + kstep); G8_TABRD(0, 0); G8_STAGE_A(G8_SA(1, 0), cA, 0, 0, kstep); G8_STAGE_U(G8_SB(1, 1), cB + hstep + kstep);
    G8_WAIT_V(6); G8_BAR;
    for (;;) {
        const bool has_next = S.next(ui + 1, nxt);
        if constexpr (Src::WAITS) { if (has_next) S.wait_tile(ui + 1); }
        if constexpr (Epi::PUBLISH) { if (ui >= 2) S.publish(ui - 2); }
        const char* nB = has_next ? S.bptr(nxt) : cB;
        const char* nA = has_next ? Ab + (size_t)(nxt.rowbase + nxt.rt * BM) * RB : cA;
#define G8_ITER(UP1, PAR1, KB1, UP2, PAR2, KB2, b2, b3) do { \
              \
            G8_TABRD(PAR1, 1); G8_SCHED; G8_LDB(B0, 0, 0); G8_SCHED; G8_LDA(At, 0, 0); G8_STAGE_A(G8_SA(1, 1), UP1, PAR1, 1, KB1); \
            G8_WAIT_L(8); G8_BAR; G8_WAIT_L(0); G8_MMA(0, 0, At, B0); G8_BAR; G8_SCHED; \
              \
            G8_LDB(B1, 0, 1); G8_STAGE_U(G8_SB(0, 0), b2); \
            G8_BAR; G8_WAIT_L(0); G8_MMA(0, 1, At, B1); G8_BAR; \
              \
            G8_TABRD(PAR2, 0); G8_SCHED; G8_LDA(At, 0, 1); G8_STAGE_A(G8_SA(0, 0), UP2, PAR2, 0, KB2); \
            G8_BAR; G8_WAIT_L(0); G8_MMA(1, 0, At, B0); G8_BAR; G8_SCHED; \
              \
            G8_STAGE_U(G8_SB(0, 1), (b2) + hstep); \
            G8_WAIT_V(6); G8_BAR; G8_MMA(1, 1, At, B1); G8_BAR; \
              \
            G8_TABRD(PAR2, 1); G8_SCHED; G8_LDB(B0, 1, 0); G8_SCHED; G8_LDA(At, 1, 0); G8_STAGE_A(G8_SA(0, 1), UP2, PAR2, 1, KB2); \
            G8_WAIT_L(8); G8_BAR; G8_WAIT_L(0); G8_MMA(0, 0, At, B0); G8_BAR; G8_SCHED; \
              \
            G8_LDB(B1, 1, 1); G8_STAGE_U(G8_SB(1, 0), b3); \
            G8_BAR; G8_WAIT_L(0); G8_MMA(0, 1, At, B1); G8_BAR; \
              \
            G8_TABRD(PAR2, 0); G8_SCHED; G8_LDA(At, 1, 1); G8_STAGE_A(G8_SA(1, 0), UP2, PAR2, 0, (KB2) + kstep); \
            G8_BAR; G8_WAIT_L(0); G8_MMA(1, 0, At, B0); G8_BAR; G8_SCHED; \
              \
            G8_STAGE_U(G8_SB(1, 1), (b3) + hstep); \
            G8_WAIT_V(6); G8_BAR; G8_MMA(1, 1, At, B1); G8_BAR; } while (0)
        { const int tp = tid_hidden(); E.prefetch(cur, lds, par, tp, __builtin_amdgcn_readfirstlane(tp >> 6)); }
        if (Src::GATHER && has_next) { const int tp = tid_hidden(); tab_fill(S, nxt, tp, __builtin_amdgcn_readfirstlane(tp >> 6), lds, par ^ 1); }
        for (int t = 0; t < NKTR - 2; t += 2) {
            const size_t k1 = (size_t)(t + 1) * kstep, k2 = (size_t)(t + 2) * kstep;
            const char* b2 = cB + k2; const char* b3 = b2 + kstep;
            G8_ITER(cA, par, k1, cA, par, k2, b2, b3);
        }
        {
            const int par2 = has_next ? (par ^ 1) : par;
            const char* b3 = nB + kstep;
            G8_ITER(cA, par, (size_t)(NKTR - 1) * kstep, nA, par2, (size_t)0, nB, b3);
        }
#undef G8_ITER
        { int tz = threadIdx.x; asm volatile("" : "+v"(tz));
          const int wid2 = __builtin_amdgcn_readfirstlane(tz >> 6), lane2 = tz & 63;
          E(acc, cur, wid2 >> 2, wid2 & 3, lane2 & 15, lane2 >> 4, lds, par); }
        if (!has_next) break;
#pragma unroll
        for (int a = 0; a < 2; ++a)
#pragma unroll
            for (int b = 0; b < 2; ++b)
#pragma unroll
                for (int m = 0; m < 4; ++m)
#pragma unroll
                    for (int n = 0; n < 2; ++n) acc[a][b][m][n] = (f32x4){0.f, 0.f, 0.f, 0.f};
        cur = nxt; cB = nB; cA = nA; ++ui; par ^= 1;
    }
    G8_WAIT_V(0);
    if (wr == 0) G8_BAR;
    G8_BAR;
    if constexpr (Epi::PUBLISH) { if (ui >= 1) S.publish(ui - 1); S.publish(ui); }
#undef G8_SA
#undef G8_SB
#undef G8_GLDS
#undef G8_STAGE_U
#undef G8_STAGE_G
#undef G8_TABRD
#undef G8_STAGE_A
#undef G8_LDA
#undef G8_LDB
#undef G8_MMA
#undef G8_WAIT_V
#undef G8_WAIT_L
#undef G8_BAR
#undef G8_SCHED
}

struct EpiGU {
    static constexpr bool PUBLISH = true;
    unsigned char* act; const float* b_gu;
    __device__ __forceinline__ void prefetch(const Unit& u, LAS unsigned char* lds, int par, int tid, int wid) const {
        if (wid >= 4) { const int i = tid - 256;
            __builtin_amdgcn_global_load_lds((const unsigned*)(b_gu + (size_t)u.e * 2048 + u.pn * 128 + (i & 127) + (i >> 7) * 1024), (LAS unsigned*)(lds + EPI_OFF + par * 2048 + (wid - 4) * 256), 4, 0, 0); }
    }
    __device__ __forceinline__ void operator()(const f32x4 (&acc)[2][2][4][2], const Unit& u, int wr, int wc, int fr, int fq, LAS unsigned char* lds, int par) const {
        LAS const float* tb = (LAS const float*)(lds + EPI_OFF + par * 2048);
        const int colu = wc * 32 + 8 * fq, col = u.pn * 128 + colu;
        const f32x4 bg0 = *(LAS const f32x4*)(tb + colu), bg1 = *(LAS const f32x4*)(tb + colu + 4), bl0 = *(LAS const f32x4*)(tb + 128 + colu), bl1 = *(LAS const f32x4*)(tb + 128 + colu + 4);
        const float sc = kf(1.f / (W8_SCALE * H28_SCALE * MX_SCALE)), lim = kf(7.f), ke = kf(-1.702f * 1.4426950408889634f), one = kf(1.f), as = kf(ACT8_SCALE);
        const f32x2_t sc2 = (f32x2_t){sc, sc}, ke2 = (f32x2_t){ke, ke}, one2 = (f32x2_t){one, one}, as2 = (f32x2_t){as, as};
#pragma unroll
        for (int ai = 0; ai < 2; ++ai)
#pragma unroll
            for (int m = 0; m < 4; ++m) {
                const int r = u.rt * BM + ai * HALF + wr * 64 + m * 16 + fr;
                f32x2_t o[4];
#pragma unroll
                for (int n = 0; n < 2; ++n)
#pragma unroll
                    for (int h = 0; h < 2; ++h) {
                        const f32x4 bgv = n ? bg1 : bg0, blv = n ? bl1 : bl0;
                        f32x2_t glu = (f32x2_t){acc[ai][0][m][n][2 * h], acc[ai][0][m][n][2 * h + 1]} * sc2 + (f32x2_t){bgv[2 * h], bgv[2 * h + 1]};
                        f32x2_t lin = (f32x2_t){acc[ai][1][m][n][2 * h], acc[ai][1][m][n][2 * h + 1]} * sc2 + (f32x2_t){blv[2 * h], blv[2 * h + 1]};
                        glu.x = fminf(glu.x, lim); glu.y = fminf(glu.y, lim);
                        lin.x = __builtin_amdgcn_fmed3f(lin.x, -lim, lim); lin.y = __builtin_amdgcn_fmed3f(lin.y, -lim, lim);
                        const f32x2_t t = glu * ke2;
                        const f32x2_t d = (f32x2_t){__builtin_amdgcn_exp2f(t.x), __builtin_amdgcn_exp2f(t.y)} + one2;
                        const f32x2_t rc = (f32x2_t){__builtin_amdgcn_rcpf(d.x), __builtin_amdgcn_rcpf(d.y)};
                        o[n * 2 + h] = (glu * rc) * (lin * as2 + as2);
                    }
                const int ro = u.rowbase + r;
                u32x2 w; w.x = cvt_pk4_fp8(o[0].x, o[0].y, o[1].x, o[1].y); w.y = cvt_pk4_fp8(o[2].x, o[2].y, o[3].x, o[3].y);
                __hip_atomic_store((unsigned long long GAS*)(act + (size_t)ro * DFF + col), ((unsigned long long)w.y << 32) | w.x, __ATOMIC_RELAXED, __HIP_MEMORY_SCOPE_AGENT);
            }
    }
};
struct EpiDown {
    static constexpr bool PUBLISH = false;
    unsigned char* y; const float* b_down; const float* lgate;
    __device__ __forceinline__ void prefetch(const Unit& u, LAS unsigned char* lds, int par, int tid, int wid) const {
        if (wid >= 4) __builtin_amdgcn_global_load_lds((const unsigned*)(b_down + (size_t)u.e * D + u.pn * BM + (tid - 256)), (LAS unsigned*)(lds + EPI_OFF + par * 2048 + (wid - 4) * 256), 4, 0, 0);
        else { int rr = u.rt * BM + tid; rr = rr < u.cnt ? rr : u.cnt - 1;
            __builtin_amdgcn_global_load_lds((const unsigned*)(lgate + (size_t)u.e * T + rr), (LAS unsigned*)(lds + EPI_OFF + par * 2048 + 1024 + wid * 256), 4, 0, 0); }
    }
    __device__ __forceinline__ void operator()(const f32x4 (&acc)[2][2][4][2], const Unit& u, int wr, int wc, int fr, int fq, LAS unsigned char* lds, int par) const {
        LAS const float* tb = (LAS const float*)(lds + EPI_OFF + par * 2048);
#pragma unroll
        for (int ai = 0; ai < 2; ++ai)
#pragma unroll
            for (int mp = 0; mp < 2; ++mp) {
                u32x2 wv[2][2];
#pragma unroll
                for (int mm = 0; mm < 2; ++mm) {
                    const int ru = ai * HALF + wr * 64 + (mp * 2 + mm) * 16 + fr;
                    const float g = tb[256 + ru] * Y8_SCALE;
#pragma unroll
                    for (int bj = 0; bj < 2; ++bj) {
                        const int colu = bj * HALF + wc * 32 + 8 * fq;
                        const f32x4 bd0 = *(LAS const f32x4*)(tb + colu), bd1 = *(LAS const f32x4*)(tb + colu + 4);
                        const f32x4 v0 = (acc[ai][bj][mp * 2 + mm][0] * (1.f / (W8_SCALE * ACT8_SCALE * MX_SCALE)) + bd0) * g;
                        const f32x4 v1 = (acc[ai][bj][mp * 2 + mm][1] * (1.f / (W8_SCALE * ACT8_SCALE * MX_SCALE)) + bd1) * g;
                        wv[mm][bj].x = cvt_pk4_fp8(v0[0], v0[1], v0[2], v0[3]); wv[mm][bj].y = cvt_pk4_fp8(v1[0], v1[1], v1[2], v1[3]);
                    }
                }
                const int ro = u.rowbase + u.rt * BM + ai * HALF + wr * 64 + (mp * 2 + (fq & 1)) * 16 + fr;
#pragma unroll
                for (int bj = 0; bj < 2; ++bj) {
                    const u32x2 sx = __builtin_amdgcn_permlane16_swap(wv[0][bj].x, wv[1][bj].x, false, false), sy = __builtin_amdgcn_permlane16_swap(wv[0][bj].y, wv[1][bj].y, false, false);
                    *(u32x4*)(y + (size_t)ro * D + u.pn * BM + bj * HALF + wc * 32 + 8 * (fq & ~1)) = (u32x4){sx.x, sy.x, sx.y, sy.y};
                }
            }
    }
};

struct DenseSrc {
    static constexpr bool GATHER = false, FP8 = false, WAITS = false;
    static constexpr int RB = KD * 2;
    const bf16_t* A; const int* ltok; const bf16_t* Bt; int nM, nN, nwg, G, c, pn0;
    __device__ __forceinline__ void init(const bf16_t* A_, const bf16_t* Bt_, int pn0_, int nN_, int G_, int c_) { A = A_; ltok = nullptr; Bt = Bt_; nM = T / BM; nN = nN_; pn0 = pn0_; nwg = nM * nN; G = G_; c = c_; }
    __device__ __forceinline__ bool next(int i, Unit& u) const {
        const int L = i * G + c; if (L >= nwg) return false;
        int wgid = L; { const int q = nwg / 8, r = nwg % 8, xcd = wgid % 8, off = wgid / 8; wgid = (xcd < r ? xcd * (q + 1) : r * (q + 1) + (xcd - r) * q) + off; }
        const int nig = 8 * nN, gid = wgid / nig, fm = gid * 8, gsz = (nM - fm) < 8 ? (nM - fm) : 8;
        u.rt = fm + ((wgid % nig) % gsz); u.pn = pn0 + (wgid % nig) / gsz; u.e = 0; u.cnt = T; u.rowbase = 0; return true;
    }
    __device__ __forceinline__ const char* bptr(const Unit& u) const { return (const char*)Bt + (size_t)u.pn * BM * KD * 2; }
};
struct EpiOutRes {
    static constexpr bool PUBLISH = false;
    bf16_t* X; const float* gate;
    __device__ __forceinline__ void prefetch(const Unit&, LAS unsigned char*, int, int, int) const {}
    __device__ __forceinline__ void operator()(const f32x4 (&acc)[2][2][4][2], const Unit& u, int wr, int wc, int fr, int fq, LAS unsigned char*, int) const {
        const int b = (u.rt * BM) / SEQ;
        const int col0 = u.pn * BM + wc * 32 + 8 * fq;
        f32x4 g[2][2];
#pragma unroll
        for (int bj = 0; bj < 2; ++bj)
#pragma unroll
            for (int n = 0; n < 2; ++n) g[bj][n] = *(const f32x4*)(gate + (size_t)b * 6 * D + col0 + bj * HALF + n * 4);
        u32x4 xn[2];
        { const bf16_t* pi = X + (size_t)(u.rt * BM + wr * 64 + fr) * D + col0;
#pragma unroll
          for (int bj = 0; bj < 2; ++bj) xn[bj] = *(const u32x4*)(pi + bj * HALF); }
#pragma unroll
        for (int g8i = 0; g8i < 8; ++g8i) {
            const int ai = g8i >> 2, m = g8i & 3;
            const size_t po = (size_t)(u.rt * BM + ai * HALF + wr * 64 + m * 16 + fr) * D + col0;
            u32x4 xv[2];
#pragma unroll
            for (int bj = 0; bj < 2; ++bj) xv[bj] = xn[bj];
            if (g8i < 7) { const int ai2 = (g8i + 1) >> 2, m2 = (g8i + 1) & 3; const bf16_t* pi = X + (size_t)(u.rt * BM + ai2 * HALF + wr * 64 + m2 * 16 + fr) * D + col0;
#pragma unroll
                for (int bj = 0; bj < 2; ++bj) xn[bj] = *(const u32x4*)(pi + bj * HALF); }
            bf16_t* p = X + po;
#pragma unroll
            for (int bj = 0; bj < 2; ++bj) {
                const u32x4 xw = xv[bj];
                const f32x4 x0 = (f32x4){__uint_as_float(xw.x << 16), __uint_as_float(xw.x & 0xffff0000u), __uint_as_float(xw.y << 16), __uint_as_float(xw.y & 0xffff0000u)};
                const f32x4 x1 = (f32x4){__uint_as_float(xw.z << 16), __uint_as_float(xw.z & 0xffff0000u), __uint_as_float(xw.w << 16), __uint_as_float(xw.w & 0xffff0000u)};
                const f32x4 r0 = x0 + g[bj][0] * acc[ai][bj][m][0], r1 = x1 + g[bj][1] * acc[ai][bj][m][1];
                u32x4 w; w.x = cvt_pk_bf16(r0[0], r0[1]); w.y = cvt_pk_bf16(r0[2], r0[3]); w.z = cvt_pk_bf16(r1[0], r1[1]); w.w = cvt_pk_bf16(r1[2], r1[3]);
                *(u32x4*)(p + bj * HALF) = w;
            }
            asm volatile("" ::: "memory");
        }
    }
};
#define EP_FENCE() asm volatile("" ::: "memory")
struct EpiProj {
    static constexpr bool PUBLISH = false;
    bf16_t* QA; bf16_t* KA; bf16_t* VTA; bf16_t* QH; bf16_t* LF; bf16_t* VTH; bf16_t* GS;
    const float* rope;
    const float* lbl;
    __device__ __forceinline__ void store_vt(bf16_t* base, unsigned voff0, const f32x4 (&acc)[2][2][4][2], int bj0, int bj1) const {
#pragma unroll
        for (int ai = 0; ai < 2; ++ai)
#pragma unroll
            for (int m = 0; m < 4; ++m) {
#pragma unroll
                for (int bj = 0; bj < 2; ++bj) {
                    if (bj < bj0 || bj > bj1) continue;
#pragma unroll
                    for (int n = 0; n < 2; ++n)
#pragma unroll
                        for (int j = 0; j < 4; ++j) {
                            const unsigned off = voff0 + (unsigned)((ai * HALF + m * 16) * 2 + ((bj - bj0) * HALF + n * 4 + j) * SEQ * 2);
                            *(bf16_t*)((char*)base + off) = f2bf(acc[ai][bj][m][n][j]);
                        }
                }
                EP_FENCE();
            }
    }
    __device__ __forceinline__ void prefetch(const Unit&, LAS unsigned char*, int, int, int) const {}
    __device__ __forceinline__ void operator()(const f32x4 (&acc)[2][2][4][2], const Unit& u, int wr, int wc, int fr, int fq, LAS unsigned char*, int) const {
        const int pn = u.pn;
        const int row0 = u.rt * BM + wr * 64 + fr;
        if (pn <= 2) {
            if (pn == 2) {
                const int b = row0 / SEQ, sp = row0 % SEQ;
                store_vt(VTA, (unsigned)(((b * 128 + wc * 32 + 8 * fq) * SEQ + sp) * 2), acc, 1, 1);
            }
            bf16_t* dst = (pn == 2) ? KA : QA;
            const int ld = (pn == 2) ? 128 : 512;
            const float scl = (pn == 2) ? 1.f : 0.125f;
#pragma unroll
            for (int bj = 0; bj < 2; ++bj) {
                if (pn == 2 && bj == 1) continue;
                const unsigned off0 = (unsigned)((row0 * ld + (pn == 2 ? 0 : pn * BM) + bj * HALF + wc * 32 + 8 * fq) * 2);
                const bool rot = (wc & 1) == 0;
                f32x4 cn0 = (f32x4){0.f, 0.f, 0.f, 0.f}, cn1 = cn0, sn0 = cn0, sn1 = cn0;
                if (rot) { const float* rp = rope + (size_t)row0 * 16; cn0 = *(const f32x4*)rp; cn1 = *(const f32x4*)(rp + 4); sn0 = *(const f32x4*)(rp + 8); sn1 = *(const f32x4*)(rp + 12); }
#pragma unroll
                for (int g8i = 0; g8i < 8; ++g8i) {
                    const int ai = g8i >> 2, m = g8i & 3;
                    const f32x4 c0 = cn0, c1 = cn1, s0 = sn0, s1 = sn1;
                    if (rot && g8i < 7) { const int row2 = row0 + ((g8i + 1) >> 2) * HALF + ((g8i + 1) & 3) * 16; const float* rp = rope + (size_t)row2 * 16;
                        cn0 = *(const f32x4*)rp; cn1 = *(const f32x4*)(rp + 4); sn0 = *(const f32x4*)(rp + 8); sn1 = *(const f32x4*)(rp + 12); }
                    f32x4 v0 = acc[ai][bj][m][0], v1 = acc[ai][bj][m][1];
                    if (rot) {
#pragma unroll
                        for (int j = 0; j < 4; ++j) {
                            const float o0 = shx(v0[j], 16), o1 = shx(v1[j], 16);
                            v0[j] = (fq == 0) ? (v0[j] * c0[j] - o0 * s0[j]) : ((fq == 1) ? (v0[j] * c0[j] + o0 * s0[j]) : v0[j]);
                            v1[j] = (fq == 0) ? (v1[j] * c1[j] - o1 * s1[j]) : ((fq == 1) ? (v1[j] * c1[j] + o1 * s1[j]) : v1[j]);
                        }
                    }
                    u32x4 w; w.x = cvt_pk_bf16(v0[0] * scl, v0[1] * scl); w.y = cvt_pk_bf16(v0[2] * scl, v0[3] * scl);
                    w.z = cvt_pk_bf16(v1[0] * scl, v1[1] * scl); w.w = cvt_pk_bf16(v1[2] * scl, v1[3] * scl);
                    *(u32x4*)((char*)dst + off0 + (unsigned)((ai * HALF + m * 16) * ld * 2)) = w;
                    EP_FENCE();
                }
            }
        } else if (pn <= 4 || pn >= 11) {
            bf16_t* dst = (pn <= 4) ? QH : GS;
            const unsigned off0 = (unsigned)((row0 * 512 + (pn <= 4 ? (pn - 3) : (pn - 11)) * BM + wc * 32 + 8 * fq) * 2);
            const float nl = kf(-1.4426950408889634f), on = kf(1.f); const f32x2_t nl2 = (f32x2_t){nl, nl}, one2 = (f32x2_t){on, on};
#pragma unroll
            for (int ai = 0; ai < 2; ++ai)
#pragma unroll
                for (int m = 0; m < 4; ++m) {
#pragma unroll
                    for (int bj = 0; bj < 2; ++bj) {
                        const f32x4 v0 = acc[ai][bj][m][0], v1 = acc[ai][bj][m][1];
                        unsigned wq[4];
#pragma unroll
                        for (int q = 0; q < 4; ++q) {
                            const f32x2_t x = q < 2 ? (f32x2_t){v0[2 * q], v0[2 * q + 1]} : (f32x2_t){v1[2 * q - 4], v1[2 * q - 3]};
                            const f32x2_t t = x * nl2;
                            const f32x2_t d = (f32x2_t){__builtin_amdgcn_exp2f(t.x), __builtin_amdgcn_exp2f(t.y)} + one2;
                            const f32x2_t o = x * (f32x2_t){__builtin_amdgcn_rcpf(d.x), __builtin_amdgcn_rcpf(d.y)};
                            wq[q] = cvt_pk_bf16(o.x, o.y);
                        }
                        *(u32x4*)((char*)dst + off0 + (unsigned)(((ai * HALF + m * 16) * 512 + bj * HALF) * 2)) = (u32x4){wq[0], wq[1], wq[2], wq[3]};
                    }
                    EP_FENCE();
                }
        } else if (pn <= 8) {
            const int cb = (pn - 5) * BM + wc * 32 + 8 * fq;
            const unsigned off0 = (unsigned)((row0 * 1024 + cb) * 2);
            const float nl = kf(-1.4426950408889634f), on = kf(1.f), l2 = kf(0.6931471805599453f); const f32x2_t nl2 = (f32x2_t){nl, nl}, one2 = (f32x2_t){on, on}, l22 = (f32x2_t){l2, l2};
            f32x4 lbv[2][2];
#pragma unroll
            for (int bj = 0; bj < 2; ++bj)
#pragma unroll
                for (int n = 0; n < 2; ++n) lbv[bj][n] = *(const f32x4*)(lbl + cb + bj * HALF + n * 4);
#pragma unroll
            for (int bj = 0; bj < 2; ++bj) {
#pragma unroll
                for (int ai = 0; ai < 2; ++ai)
#pragma unroll
                    for (int m = 0; m < 4; ++m) {
                        const f32x4 v0 = acc[ai][bj][m][0], v1 = acc[ai][bj][m][1];
                        unsigned wq[4];
#pragma unroll
                        for (int q = 0; q < 4; ++q) {
                            const f32x2_t x = q < 2 ? (f32x2_t){v0[2 * q], v0[2 * q + 1]} : (f32x2_t){v1[2 * q - 4], v1[2 * q - 3]};
                            const f32x4 lbq = lbv[bj][q >> 1];
                            const f32x2_t lb = (f32x2_t){lbq[2 * (q & 1)], lbq[2 * (q & 1) + 1]};
                            const f32x2_t t = x * nl2;
                            const f32x2_t d = (f32x2_t){__builtin_amdgcn_exp2f(t.x), __builtin_amdgcn_exp2f(t.y)} + one2;
                            const f32x2_t f = (one2 - lb) * (f32x2_t){__builtin_amdgcn_rcpf(d.x), __builtin_amdgcn_rcpf(d.y)} + lb;
                            const f32x2_t o = (f32x2_t){__builtin_amdgcn_logf(fmaxf(f.x, 1e-30f)), __builtin_amdgcn_logf(fmaxf(f.y, 1e-30f))} * l22;
                            wq[q] = cvt_pk_bf16(o.x, o.y);
                        }
                        *(u32x4*)((char*)LF + off0 + (unsigned)(((ai * HALF + m * 16) * 1024 + bj * HALF) * 2)) = (u32x4){wq[0], wq[1], wq[2], wq[3]};
                    }
                EP_FENCE();
            }
        } else {
            const int b = row0 / SEQ, sp = row0 % SEQ;
            store_vt(VTH, (unsigned)(((b * 512 + (pn - 9) * BM + wc * 32 + 8 * fq) * SEQ + sp) * 2), acc, 0, 1);
        }
    }
};
}
namespace att {
constexpr int KROW = 128;
constexpr int VROW = 816;
constexpr int K_BYTES = 400 * KROW;
constexpr int V_OFF = K_BYTES;
constexpr int LDS_BYTES = V_OFF + 64 * VROW;
__device__ __forceinline__ void attn_phase(LAS unsigned char* lds, const bf16_t* __restrict__ QA, const bf16_t* __restrict__ KA, const bf16_t* __restrict__ VTA,
                                           const float* __restrict__ sink_l, bf16_t* __restrict__ AO, float* __restrict__ SSQ, int first, int count, int stride) {
    const int tid = tid_hidden(), wid = __builtin_amdgcn_readfirstlane(tid >> 6), lane = tid & 63, l15 = lane & 15, g4 = lane >> 4;
    for (int it = 0; it < count; ++it) {
        const int item = first + it * stride;
        const int b = item >> 5, qb = (item >> 1) & 15, kvh = item & 1;
        const int kb0 = qb * 128 - 128;
        unsigned z0 = 0u; asm volatile("" : "+v"(z0));
        const u32x4 zz = (u32x4){z0, z0, z0, z0};
        const int hg = wid >> 1, head = kvh * 4 + hg, half = wid & 1;
        const int kc0 = ((g4 ^ (l15 & 7)) * 16);
        const float sk = sink_l[head];
        bf16x8 q0n, q1n;
        { const size_t tokn = (size_t)b * SEQ + qb * 128 + half * 64 + l15;
          q0n = *(const bf16x8*)(QA + tokn * 512 + head * 64 + 8 * g4); q1n = *(const bf16x8*)(QA + tokn * 512 + head * 64 + 32 + 8 * g4); }
        __syncthreads();
#pragma unroll
        for (int i = 0; i < 6; ++i) {
            const int ch = tid + i * 512, kap = ch >> 3, part = ch & 7, kpos = kb0 + kap;
            u32x4 v = zz;
            if (kpos >= 0 && kpos < SEQ) v = *(const u32x4*)(KA + (size_t)(b * SEQ + kpos) * 128 + kvh * 64 + part * 8);
            *(LAS u32x4*)(lds + kap * KROW + ((part ^ (kap & 7)) * 16)) = v;
        }
        if (tid < 128) { const int kap = 384 + (tid >> 3), part = tid & 7; *(LAS u32x4*)(lds + kap * KROW + part * 16) = zz; }
#pragma unroll
        for (int i = 0; i < 6; ++i) {
            const int ch = tid + i * 512, d = ch / 48, kc = ch - d * 48, kpos = kb0 + kc * 8;
            u32x4 v = zz;
            if (kpos >= 0 && kpos < SEQ) v = *(const u32x4*)(VTA + ((size_t)b * 128 + kvh * 64 + d) * SEQ + kpos);
            *(LAS u32x4*)(lds + V_OFF + d * VROW + kc * 16) = v;
        }
        if (tid < 192) { const int d = tid / 3, kc = 48 + (tid - d * 3); *(LAS u32x4*)(lds + V_OFF + d * VROW + kc * 16) = zz; }
        __syncthreads();
#pragma unroll 1
        for (int blk = 0; blk < 4; ++blk) {
            const int t0 = half * 4 + blk, qr0 = t0 * 16, qo = qr0 + l15;
            const size_t tok = (size_t)b * SEQ + qb * 128 + qo;
            const bf16x8 q0 = q0n, q1 = q1n;
            if (blk < 3) { const size_t tokn = tok + 16; q0n = *(const bf16x8*)(QA + tokn * 512 + head * 64 + 8 * g4); q1n = *(const bf16x8*)(QA + tokn * 512 + head * 64 + 32 + 8 * g4); }
            f32x4 sc[18];
            float mx = sk;
#pragma unroll
            for (int i = 0; i < 18; ++i) {
                const LAS unsigned char* kp = lds + ((t0 + i) * 16 + l15) * KROW;
                const bf16x8 k0 = *(const LAS bf16x8*)(kp + kc0), k1 = *(const LAS bf16x8*)(kp + (kc0 ^ 64));
                f32x4 a = (f32x4){0.f, 0.f, 0.f, 0.f};
                a = __builtin_amdgcn_mfma_f32_16x16x32_bf16(k0, q0, a, 0, 0, 0);
                a = __builtin_amdgcn_mfma_f32_16x16x32_bf16(k1, q1, a, 0, 0, 0);
#pragma unroll
                for (int r = 0; r < 4; ++r) {
                    const int kap = (t0 + i) * 16 + 4 * g4 + r, rel = kap - qo, kpos = kb0 + kap;
                    const bool ok = (rel >= 0) && (rel <= 256) && (kpos >= 0) && (kpos < SEQ);
                    a[r] = ok ? a[r] : kf(-1e30f);
                    mx = fmaxf(mx, a[r]);
                }
                sc[i] = a;
            }
            mx = fmaxf(mx, shx(mx, 16)); mx = fmaxf(mx, shx(mx, 32));
            float sum = 0.f;
#pragma unroll
            for (int i = 0; i < 18; ++i)
#pragma unroll
                for (int r = 0; r < 4; ++r) { const float p = fexp(sc[i][r] - mx); sc[i][r] = p; sum += p; }
            sum += shx(sum, 16); sum += shx(sum, 32);
            sum += fexp(sk - mx);
            f32x4 o[4];
#pragma unroll
            for (int dt = 0; dt < 4; ++dt) o[dt] = (f32x4){0.f, 0.f, 0.f, 0.f};
#pragma unroll
            for (int u = 0; u < 9; ++u) {
                u32x4 pw; pw.x = cvt_pk_bf16(sc[2 * u][0], sc[2 * u][1]); pw.y = cvt_pk_bf16(sc[2 * u][2], sc[2 * u][3]);
                pw.z = cvt_pk_bf16(sc[2 * u + 1][0], sc[2 * u + 1][1]); pw.w = cvt_pk_bf16(sc[2 * u + 1][2], sc[2 * u + 1][3]);
                const bf16x8 pf = __builtin_bit_cast(bf16x8, pw);
#pragma unroll
                for (int dt = 0; dt < 4; ++dt) {
                    const LAS unsigned char* vp = lds + V_OFF + (dt * 16 + l15) * VROW + ((t0 + 2 * u) * 16 + 4 * g4) * 2;
                    const u32x2 va = *(const LAS u32x2*)vp, vb = *(const LAS u32x2*)(vp + 32);
                    const bf16x8 vf = __builtin_bit_cast(bf16x8, (u32x4){va.x, va.y, vb.x, vb.y});
                    o[dt] = __builtin_amdgcn_mfma_f32_16x16x32_bf16(vf, pf, o[dt], 0, 0, 0);
                }
            }
            const float inv = 1.f / sum;
            float ss = 0.f;
#pragma unroll
            for (int dt = 0; dt < 4; ++dt) {
                const f32x4 v = o[dt] * inv;
                ss += v[0] * v[0] + v[1] * v[1] + v[2] * v[2] + v[3] * v[3];
                u32x2 w; w.x = cvt_pk_bf16(v[0], v[1]); w.y = cvt_pk_bf16(v[2], v[3]);
                *(u32x2*)(AO + tok * 512 + head * 64 + dt * 16 + 4 * g4) = w;
            }
            ss += shx(ss, 16); ss += shx(ss, 32);
            if (g4 == 0) SSQ[tok * 8 + head] = ss;
        }
    }
}
}
namespace hg {
constexpr int R144 = 144, R272 = 272;
constexpr int C1_KD = 0, C1_VT = 128 * R144, C1_QT = 2 * 128 * R144, C1_BYTES = C1_QT + 2048;
constexpr int C3_QT = 0, C3_QH = 64 * R272, C3_KH = 2 * 64 * R272, C3_VT = 3 * 64 * R272, C3_ST = C3_VT + 128 * R144, C3_QTOT = C3_ST + 128 * R272, C3_RED = C3_QTOT + 2048, C3_BYTES = C3_RED + 512;

__device__ __forceinline__ void c1_phase(LAS unsigned char* lds, const bf16_t* __restrict__ LF, const bf16_t* __restrict__ VTH, bf16_t* __restrict__ UT, float* __restrict__ DEC, int first, int count, int stride) {
    const int tid = tid_hidden(), wid = __builtin_amdgcn_readfirstlane(tid >> 6), lane = tid & 63, l15 = lane & 15, g4 = lane >> 4;
    const int d = tid & 127, tq = tid >> 7;
    LAS float* qtot = (LAS float*)(lds + C1_QT);
    unsigned lfn[16]; u32x4 vtn[2];
#define C1_PF_LF(ITEM, DIR) do { const int b_ = (ITEM) >> 7, h_ = ((ITEM) >> 5) & 3, j_ = (ITEM) & 31; const size_t tk_ = (size_t)b_ * SEQ + j_ * 64; \
        _Pragma("unroll") for (int i = 0; i < 16; ++i) lfn[i] = (unsigned)((const unsigned short*)LF)[(tk_ + tq * 16 + i) * 1024 + (DIR) * 512 + h_ * 128 + d]; } while (0)
#define C1_PF_VT(ITEM) do { const int b_ = (ITEM) >> 7, h_ = ((ITEM) >> 5) & 3, j_ = (ITEM) & 31; \
        _Pragma("unroll") for (int i = 0; i < 2; ++i) { const int ch = tid + i * 512, e = ch >> 3, part = ch & 7; vtn[i] = *(const u32x4*)(VTH + ((size_t)b_ * 512 + h_ * 128 + e) * SEQ + j_ * 64 + part * 8); } } while (0)
    if (count > 0) { C1_PF_VT(first); C1_PF_LF(first, 0); }
    for (int it = 0; it < count; ++it) {
        const int item = first + it * stride;
        const int b = item >> 7, h = (item >> 5) & 3, j = item & 31;
        __syncthreads();
#pragma unroll
        for (int i = 0; i < 2; ++i) { const int ch = tid + i * 512, e = ch >> 3, part = ch & 7;
            *(LAS u32x4*)(lds + C1_VT + e * R144 + part * 16) = vtn[i]; }
        if (it + 1 < count) C1_PF_VT(item + stride);
#pragma unroll 1
        for (int dir = 0; dir < 2; ++dir) {
            float lfv[16], cs[16];
#pragma unroll
            for (int i = 0; i < 16; ++i) lfv[i] = __uint_as_float(lfn[i] << 16);
            if (dir == 0) C1_PF_LF(item, 1); else if (it + 1 < count) C1_PF_LF(item + stride, 0);
            float run = 0.f;
#pragma unroll
            for (int i = 0; i < 16; ++i) { run += lfv[i]; cs[i] = run; }
            __syncthreads();
            qtot[tq * 128 + d] = run;
            __syncthreads();
            const float q0 = qtot[d], q1 = qtot[128 + d], q2 = qtot[256 + d], q3 = qtot[384 + d];
            const float pre = (tq > 0 ? q0 : 0.f) + (tq > 1 ? q1 : 0.f) + (tq > 2 ? q2 : 0.f), total = (q0 + q1) + (q2 + q3);
            unsigned w[8];
#pragma unroll
            for (int i = 0; i < 16; i += 2) {
                float kd[2];
#pragma unroll
                for (int k = 0; k < 2; ++k) {
                    const float key = 1.f - fexp(lfv[i + k]);
                    const float ex = dir == 0 ? (total - (pre + cs[i + k])) : (pre + cs[i + k] - lfv[i + k]);
                    kd[k] = key * fexp(ex);
                }
                w[i >> 1] = cvt_pk_bf16(kd[0], kd[1]);
            }
            *(LAS u32x4*)(lds + C1_KD + d * R144 + tq * 32) = (u32x4){w[0], w[1], w[2], w[3]};
            *(LAS u32x4*)(lds + C1_KD + d * R144 + tq * 32 + 16) = (u32x4){w[4], w[5], w[6], w[7]};
            const size_t idx = ((size_t)(dir * NB + b) * 4 + h) * 32 + j;
            if (tq == 0) DEC[idx * 128 + d] = fexp(total);
            __syncthreads();
            bf16x8 af[2];
#pragma unroll
            for (int ks = 0; ks < 2; ++ks) af[ks] = *(const LAS bf16x8*)(lds + C1_KD + (wid * 16 + l15) * R144 + ks * 64 + g4 * 16);
#pragma unroll
            for (int et = 0; et < 8; ++et) {
                f32x4 a = (f32x4){0.f, 0.f, 0.f, 0.f};
#pragma unroll
                for (int ks = 0; ks < 2; ++ks) {
                    const bf16x8 bfv = *(const LAS bf16x8*)(lds + C1_VT + (et * 16 + l15) * R144 + ks * 64 + g4 * 16);
                    a = __builtin_amdgcn_mfma_f32_16x16x32_bf16(af[ks], bfv, a, 0, 0, 0);
                }
                u32x2 o; o.x = cvt_pk_bf16(a[0], a[1]); o.y = cvt_pk_bf16(a[2], a[3]);
                *(u32x2*)(UT + idx * 16384 + (size_t)(et * 16 + l15) * 128 + wid * 16 + 4 * g4) = o;
            }
        }
    }
}
#undef C1_PF_LF
#undef C1_PF_VT
__device__ __forceinline__ void c2_phase(const bf16_t* __restrict__ UT, const float* __restrict__ DEC, bf16_t* __restrict__ SIN, int G, int c) {
    for (int w = c * 512 + tid_hidden(); w < 64 * 2048; w += G * 512) {
        const int seq = w >> 11, e = (w >> 4) & 127, d8 = (w & 15) * 8, dir = seq >> 5;
        float S[8];
#pragma unroll
        for (int k = 0; k < 8; ++k) S[k] = 0.f;
#pragma unroll 4
        for (int step = 0; step < 32; ++step) {
            const int j = dir ? 31 - step : step;
            const size_t idx = (size_t)seq * 32 + j;
            const u32x4 u = *(const u32x4*)(UT + idx * 16384 + e * 128 + d8);
            const f32x4 dc0 = *(const f32x4*)(DEC + idx * 128 + d8), dc1 = *(const f32x4*)(DEC + idx * 128 + d8 + 4);
            u32x4 o; o.x = cvt_pk_bf16(S[0], S[1]); o.y = cvt_pk_bf16(S[2], S[3]); o.z = cvt_pk_bf16(S[4], S[5]); o.w = cvt_pk_bf16(S[6], S[7]);
            *(u32x4*)(SIN + idx * 16384 + e * 128 + d8) = o;
            S[0] = dc0[0] * S[0] + __uint_as_float(u.x << 16); S[1] = dc0[1] * S[1] + __uint_as_float(u.x & 0xffff0000u);
            S[2] = dc0[2] * S[2] + __uint_as_float(u.y << 16); S[3] = dc0[3] * S[3] + __uint_as_float(u.y & 0xffff0000u);
            S[4] = dc1[0] * S[4] + __uint_as_float(u.z << 16); S[5] = dc1[1] * S[5] + __uint_as_float(u.z & 0xffff0000u);
            S[6] = dc1[2] * S[6] + __uint_as_float(u.w << 16); S[7] = dc1[3] * S[7] + __uint_as_float(u.w & 0xffff0000u);
        }
    }
}
__device__ __forceinline__ void c3_phase(LAS unsigned char* lds, const bf16_t* __restrict__ QH, const bf16_t* __restrict__ LF, const bf16_t* __restrict__ VTH, const bf16_t* __restrict__ SIN,
                                         const bf16_t* __restrict__ GS, const float* __restrict__ hg_gain, const bf16_t* __restrict__ AO, const float* __restrict__ SSQ,
                                         const float* __restrict__ attn_gain, bf16_t* __restrict__ MIX, int G, int c) {
    const int tid = tid_hidden(), wid = __builtin_amdgcn_readfirstlane(tid >> 6), lane = tid & 63, l15 = lane & 15, g4 = lane >> 4;
    const int d = tid & 127, tq = tid >> 7, tau = wid & 3, eh = wid >> 2;
    LAS float* qtot = (LAS float*)(lds + C3_QTOT);
    LAS float* red = (LAS float*)(lds + C3_RED);
    unsigned lfn[16]; u32x4 stn[4];
#define C3_PREFETCH(ITEM, DIR) do { const int b_ = (ITEM) >> 7, h_ = ((ITEM) >> 5) & 3, j_ = (ITEM) & 31; const size_t tk_ = (size_t)b_ * SEQ + j_ * 64; \
        const size_t ix_ = ((size_t)((DIR) * NB + b_) * 4 + h_) * 32 + j_; \
        _Pragma("unroll") for (int i = 0; i < 16; ++i) lfn[i] = (unsigned)((const unsigned short*)LF)[(tk_ + tq * 16 + i) * 1024 + (DIR) * 512 + h_ * 128 + d]; \
        _Pragma("unroll") for (int i = 0; i < 4; ++i) { const int ch = tid + i * 512, e = ch >> 4, part = ch & 15; stn[i] = *(const u32x4*)(SIN + ix_ * 16384 + e * 128 + part * 8); } } while (0)
    if (c < NB * 4 * 32) C3_PREFETCH(c, 0);
    for (int item = c; item < NB * 4 * 32; item += G) {
        const int b = item >> 7, h = (item >> 5) & 3, j = item & 31;
        const size_t tok0 = (size_t)b * SEQ + j * 64;
        { const int t = tid >> 3, c16 = (tid & 7) * 16; const size_t tok = tok0 + t;
          const f32x4 s0 = *(const f32x4*)(SSQ + tok * 8), s1 = *(const f32x4*)(SSQ + tok * 8 + 4);
          const float r = rsqrtf(((s0[0] + s0[1]) + (s0[2] + s0[3]) + (s1[0] + s1[1]) + (s1[2] + s1[3])) * (1.f / 512) + kf(EPS));
#pragma unroll
          for (int k = 0; k < 2; ++k) {
              const u32x4 a = *(const u32x4*)(AO + tok * 512 + h * 128 + c16 + k * 8);
              const f32x4 g0 = *(const f32x4*)(attn_gain + h * 128 + c16 + k * 8), g1 = *(const f32x4*)(attn_gain + h * 128 + c16 + k * 8 + 4);
              u32x4 o;
              o.x = cvt_pk_bf16(__uint_as_float(a.x << 16) * r * g0[0], __uint_as_float(a.x & 0xffff0000u) * r * g0[1]);
              o.y = cvt_pk_bf16(__uint_as_float(a.y << 16) * r * g0[2], __uint_as_float(a.y & 0xffff0000u) * r * g0[3]);
              o.z = cvt_pk_bf16(__uint_as_float(a.z << 16) * r * g1[0], __uint_as_float(a.z & 0xffff0000u) * r * g1[1]);
              o.w = cvt_pk_bf16(__uint_as_float(a.w << 16) * r * g1[2], __uint_as_float(a.w & 0xffff0000u) * r * g1[3]);
              *(u32x4*)(MIX + tok * D + h * 128 + c16 + k * 8) = o;
          } }
        __syncthreads();
#pragma unroll
        for (int i = 0; i < 2; ++i) { const int ch = tid + i * 512, e = ch >> 3, part = ch & 7;
            *(LAS u32x4*)(lds + C3_VT + e * R144 + part * 16) = *(const u32x4*)(VTH + ((size_t)b * 512 + h * 128 + e) * SEQ + j * 64 + part * 8); }
        f32x4 o[4];
#pragma unroll
        for (int et = 0; et < 4; ++et) o[et] = (f32x4){0.f, 0.f, 0.f, 0.f};
        float qv[16];
#pragma unroll
        for (int i = 0; i < 16; ++i) qv[i] = bf2f(QH[(tok0 + tq * 16 + i) * 512 + h * 128 + d]);
#pragma unroll 1
        for (int dir = 0; dir < 2; ++dir) {
            const size_t idx = ((size_t)(dir * NB + b) * 4 + h) * 32 + j;
            float lfv[16], cs[16]; u32x4 stv[4];
#pragma unroll
            for (int i = 0; i < 16; ++i) lfv[i] = __uint_as_float(lfn[i] << 16);
#pragma unroll
            for (int i = 0; i < 4; ++i) stv[i] = stn[i];
            float run = 0.f;
#pragma unroll
            for (int i = 0; i < 16; ++i) { run += lfv[i]; cs[i] = run; }
            __syncthreads();
            qtot[tq * 128 + d] = run;
#pragma unroll
            for (int i = 0; i < 4; ++i) { const int ch = tid + i * 512, e = ch >> 4, part = ch & 15;
                *(LAS u32x4*)(lds + C3_ST + e * R272 + part * 16) = stv[i]; }
            __syncthreads();
            const float q0 = qtot[d], q1 = qtot[128 + d], q2 = qtot[256 + d], q3 = qtot[384 + d];
            const float pre = (tq > 0 ? q0 : 0.f) + (tq > 1 ? q1 : 0.f) + (tq > 2 ? q2 : 0.f), total = (q0 + q1) + (q2 + q3);
            const float mref = dir == 0 ? (q0 + q1) : (q2 + q3);
#pragma unroll
            for (int i = 0; i < 16; ++i) {
                const int t = tq * 16 + i;
                const float bt = dir == 0 ? (pre + cs[i]) : (total - (pre + cs[i]) + lfv[i]);
                const float q = qv[i];
                const float key = 1.f - fexp(lfv[i]);
                *(LAS bf16_t*)(lds + C3_QT + t * R272 + d * 2) = f2bf(q * fexp(bt));
                *(LAS bf16_t*)(lds + C3_QH + t * R272 + d * 2) = f2bf(q * fexp(fminf(bt - mref, 80.f)));
                *(LAS bf16_t*)(lds + C3_KH + t * R272 + d * 2) = f2bf(key * fexp(fminf(mref - bt, 80.f)));
            }
            __syncthreads();
            if (dir == 0) C3_PREFETCH(item, 1); else if (item + G < NB * 4 * 32) C3_PREFETCH(item + G, 0);
            bf16x8 qf[4];
#pragma unroll
            for (int ks = 0; ks < 4; ++ks) qf[ks] = *(const LAS bf16x8*)(lds + C3_QH + (tau * 16 + l15) * R272 + ks * 64 + g4 * 16);
            f32x4 sc[4];
#pragma unroll
            for (int sg = 0; sg < 4; ++sg) {
                f32x4 a = (f32x4){0.f, 0.f, 0.f, 0.f};
                const bool need = dir == 0 ? (sg <= tau) : (sg >= tau);
                if (need) {
#pragma unroll
                    for (int ks = 0; ks < 4; ++ks) {
                        const bf16x8 kf = *(const LAS bf16x8*)(lds + C3_KH + (sg * 16 + l15) * R272 + ks * 64 + g4 * 16);
                        a = __builtin_amdgcn_mfma_f32_16x16x32_bf16(kf, qf[ks], a, 0, 0, 0);
                    }
#pragma unroll
                    for (int r = 0; r < 4; ++r) { const int sp = sg * 16 + 4 * g4 + r, tp = tau * 16 + l15; const bool ok = dir == 0 ? (sp <= tp) : (sp >= tp); a[r] = ok ? a[r] : 0.f; }
                }
                sc[sg] = a;
            }
#pragma unroll
            for (int ks = 0; ks < 4; ++ks) qf[ks] = *(const LAS bf16x8*)(lds + C3_QT + (tau * 16 + l15) * R272 + ks * 64 + g4 * 16);
#pragma unroll
            for (int et = 0; et < 4; ++et) {
                const int erow = (eh * 4 + et) * 16 + l15;
#pragma unroll
                for (int up = 0; up < 2; ++up) {
                    u32x4 pw; pw.x = cvt_pk_bf16(sc[2 * up][0], sc[2 * up][1]); pw.y = cvt_pk_bf16(sc[2 * up][2], sc[2 * up][3]);
                    pw.z = cvt_pk_bf16(sc[2 * up + 1][0], sc[2 * up + 1][1]); pw.w = cvt_pk_bf16(sc[2 * up + 1][2], sc[2 * up + 1][3]);
                    const LAS unsigned char* vp = lds + C3_VT + erow * R144 + (up * 32 + 4 * g4) * 2;
                    const u32x2 va = *(const LAS u32x2*)vp, vb = *(const LAS u32x2*)(vp + 32);
                    o[et] = __builtin_amdgcn_mfma_f32_16x16x32_bf16(__builtin_bit_cast(bf16x8, (u32x4){va.x, va.y, vb.x, vb.y}), __builtin_bit_cast(bf16x8, pw), o[et], 0, 0, 0);
                }
#pragma unroll
                for (int ks = 0; ks < 4; ++ks) {
                    const bf16x8 sf = *(const LAS bf16x8*)(lds + C3_ST + erow * R272 + ks * 64 + g4 * 16);
                    o[et] = __builtin_amdgcn_mfma_f32_16x16x32_bf16(sf, qf[ks], o[et], 0, 0, 0);
                }
            }
        }
        float ss = 0.f;
#pragma unroll
        for (int et = 0; et < 4; ++et) ss += o[et][0] * o[et][0] + o[et][1] * o[et][1] + o[et][2] * o[et][2] + o[et][3] * o[et][3];
        ss += shx(ss, 16); ss += shx(ss, 32);
        if (g4 == 0) red[wid * 16 + l15] = ss;
        __syncthreads();
        const float tot = red[wid * 16 + l15] + red[(wid ^ 4) * 16 + l15];
        const float rr = rsqrtf(tot * (1.f / 128) + kf(EPS));
        const size_t tok = tok0 + tau * 16 + l15;
#pragma unroll
        for (int et = 0; et < 4; ++et) {
            const int e0 = (eh * 4 + et) * 16 + 4 * g4;
            const f32x4 gn = *(const f32x4*)(hg_gain + e0);
            const u32x2 gv = *(const u32x2*)(GS + tok * 512 + h * 128 + e0);
            u32x2 w;
            w.x = cvt_pk_bf16(o[et][0] * rr * gn[0] * __uint_as_float(gv.x << 16), o[et][1] * rr * gn[1] * __uint_as_float(gv.x & 0xffff0000u));
            w.y = cvt_pk_bf16(o[et][2] * rr * gn[2] * __uint_as_float(gv.y << 16), o[et][3] * rr * gn[3] * __uint_as_float(gv.y & 0xffff0000u));
            *(u32x2*)(MIX + tok * D + 512 + h * 128 + e0) = w;
        }
    }
}
#undef C3_PREFETCH
}

#define XB_TMO      128
#define XB_XCNT(j)  (256  + 64 * (j))
#define XB_XSUB(j)  (1280 + 64 * (j))
#define XB_XGEN(j)  (2304 + 64 * (j))
#define XB_TOP      3328
#define XB_TOPGEN   3392
#define XCD_BAR_WORDS 3456
#define XB_SPIN_CAP (1u << 18)
__device__ __forceinline__ unsigned xb_xcc_id() { return (unsigned)__builtin_amdgcn_s_getreg((3 << 11) | 20) & 0xFu; }
#define XB_SPIN(cond, bar) do { unsigned _sp = 0; while (cond) { __builtin_amdgcn_s_sleep(1); \
    if ((++_sp & 255u) == 0u) { if (xb_ld(&(bar)[XB_TMO])) break; if (_sp > XB_SPIN_CAP) { (void)xb_add(&(bar)[XB_TMO], 1u); break; } } } } while (0)
struct XcdBarrier { unsigned* bar; unsigned x; volatile LAS unsigned* st; };
__device__ __forceinline__ XcdBarrier xcd_barrier_post(unsigned* bar, volatile LAS unsigned* st) {
    XcdBarrier b; b.bar = bar; b.x = xb_xcc_id(); b.st = st;
    if (threadIdx.x == 0) (void)xb_add(&bar[XB_XCNT(b.x)], 1u);
    return b;
}
__device__ __forceinline__ void xcd_barrier_complete(unsigned* bar, unsigned x, unsigned& nloc, unsigned& nx) {
    const unsigned G = gridDim.x * gridDim.y * gridDim.z;
    unsigned sum, cnt, sp = 0u;
    for (;;) {
        sum = 0u; cnt = 0u;
#pragma unroll 1
        for (unsigned j = 0; j < 16; ++j) { const unsigned c = xb_ld(&bar[XB_XCNT(j)]); sum += c; cnt += (c > 0u) ? 1u : 0u; }
        if (sum == G) break;
        __builtin_amdgcn_s_sleep(1);
        if ((++sp & 255u) == 0u) { if (xb_ld(&bar[XB_TMO])) break; if (sp > XB_SPIN_CAP) { (void)xb_add(&bar[XB_TMO], 1u); break; } }
    }
    const unsigned mine = xb_ld(&bar[XB_XCNT(x)]);
    nloc = mine > 0u ? mine : 1u; nx = cnt > 0u ? cnt : 1u;
}
__device__ __forceinline__ void xcd_barrier(const XcdBarrier& b) {
    asm volatile("s_waitcnt vmcnt(0)" ::: "memory");
    __syncthreads();
    if (threadIdx.x == 0) {
        unsigned* bar = b.bar;
        __builtin_amdgcn_s_waitcnt(0);
        unsigned nloc = b.st[0], nx = b.st[1];
        if (nloc == 0u) { xcd_barrier_complete(bar, b.x, nloc, nx); b.st[0] = nloc; b.st[1] = nx; }
        const unsigned old = xb_add(&bar[XB_XSUB(b.x)], 1u);
        const unsigned gen = old / nloc;
        if (old + 1u == (gen + 1u) * nloc) {
            __builtin_amdgcn_fence(__ATOMIC_RELEASE, "agent");
            asm volatile("s_waitcnt vmcnt(0)" ::: "memory");
            const unsigned og = xb_add(&bar[XB_TOP], 1u);
            const unsigned tg = og / nx;
            if (og + 1u == (tg + 1u) * nx) xb_add(&bar[XB_TOPGEN], 1u);
            else XB_SPIN(xb_ld(&bar[XB_TOPGEN]) == tg, bar);
            __builtin_amdgcn_fence(__ATOMIC_ACQUIRE, "agent");
            xb_add(&bar[XB_XGEN(b.x)], 1u);
            asm volatile("s_waitcnt vmcnt(0)" ::: "memory");
        } else {
            XB_SPIN(xb_ld(&bar[XB_XGEN(b.x)]) == gen, bar);
            __builtin_amdgcn_fence(__ATOMIC_ACQUIRE, "agent");
            asm volatile("s_waitcnt vmcnt(0)" ::: "memory");
        }
    }
    __syncthreads();
}

constexpr size_t al(size_t x) { return (x + 255) & ~(size_t)255; }
constexpr size_t CTL_BYTES = 32768;
constexpr size_t W_CNT = 13824;
constexpr size_t W_DONE = 16384;
constexpr size_t W_X = CTL_BYTES;
constexpr size_t W_H1B = W_X + al((size_t)T * D * 4);
constexpr size_t W_MIXB = W_H1B + al((size_t)T * D * 2);
constexpr size_t W_H2B = W_MIXB + al((size_t)T * D * 2);
constexpr size_t W_QA = W_H2B + al((size_t)T * D * 2);
constexpr size_t W_KA = W_QA + al((size_t)T * 512 * 2);
constexpr size_t W_VTA = W_KA + al((size_t)T * 128 * 2);
constexpr size_t W_QH = W_VTA + al((size_t)T * 128 * 2);
constexpr size_t W_LF = W_QH + al((size_t)T * 512 * 2);
constexpr size_t W_VTH = W_LF + al((size_t)T * 1024 * 4);
constexpr size_t W_GS = W_VTH + al((size_t)T * 512 * 2);
constexpr size_t W_AO = W_GS + al((size_t)T * 512 * 2);
constexpr size_t W_SSQ = W_AO + al((size_t)T * 512 * 2);
constexpr size_t W_UT = W_SSQ + al((size_t)T * 8 * 4);
constexpr size_t W_SIN = W_UT + al((size_t)2048 * 16384 * 2);
constexpr size_t W_DEC = W_SIN + al((size_t)2048 * 16384 * 2);
constexpr size_t W_MOD = W_DEC + al((size_t)2048 * 128 * 4);
constexpr size_t W_LOW = W_MOD + al((size_t)DEPTH * NB * 6 * D * 4);
constexpr size_t W_ROPE = W_LOW + al((size_t)DEPTH * 1024 * 4);
constexpr size_t W_WRP = W_ROPE + al((size_t)T * 16 * 4);
constexpr size_t W_BRP = W_WRP + al((size_t)DEPTH * NB * D * NE * 4);
constexpr size_t W_LTOK = W_BRP + al((size_t)DEPTH * NB * NE * 4);
constexpr size_t W_LGATE = W_LTOK + al((size_t)NE * T * 4);
constexpr size_t W_PE = W_LGATE + al((size_t)NE * T * 4);
constexpr size_t W_PR = W_PE + al((size_t)NP * 4);
constexpr size_t W_ACTB = W_PR + al((size_t)NP * 4);
constexpr size_t W_YB = W_ACTB + al((size_t)(NP + NE * 256) * 1024 * 2);
constexpr size_t W_WINT = W_YB + al((size_t)(NP + NE * 256) * 1024 * 2);
constexpr size_t W_WOUTT = W_WINT + al((size_t)DEPTH * INW * 1024 * 2);
constexpr size_t W_WGUT = W_WOUTT + al((size_t)DEPTH * D * 1024 * 2);
constexpr size_t W_WDT = W_WGUT + al((size_t)DEPTH * NE * 2048 * 1024 * 2);
constexpr size_t W_END = W_WDT + al((size_t)DEPTH * NE * 1024 * 1024 * 2);

constexpr int LDS_BAR_OFF = g8::LDS_TOTAL - 64;

struct Args {
    const float* x; const float* c; const int* pos; const float* w_ada; const float* b_ada; const float* norm1; const float* w_in; const float* sink;
    const float* attn_norm; const float* lbl; const float* hg_norm; const float* w_out; const float* norm2; const float* w_router; const float* b_router;
    const float* w_gu; const float* b_gu; const float* w_down; const float* b_down; const float* final_norm;
    float* out; unsigned char* ws; int ph_lo, ph_hi;
};

struct ArgsG {
    const float GAS* x; const float GAS* c; const int GAS* pos; const float GAS* w_ada; const float GAS* b_ada; const float GAS* norm1; const float GAS* w_in; const float GAS* sink;
    const float GAS* attn_norm; const float GAS* lbl; const float GAS* hg_norm; const float GAS* w_out; const float GAS* norm2; const float GAS* w_router; const float GAS* b_router;
    const float GAS* w_gu; const float GAS* b_gu; const float GAS* w_down; const float GAS* b_down; const float GAS* final_norm;
    float GAS* out; unsigned char GAS* ws; int ph_lo, ph_hi;
};
static_assert(sizeof(ArgsG) == sizeof(Args), "ArgsG layout");
typedef const ArgsG __attribute__((address_space(4)))* ArgsP;
__device__ __forceinline__ ArgsP args_hidden() { ArgsP p = (ArgsP)__builtin_amdgcn_kernarg_segment_ptr(); asm volatile("" : "+s"(p)); return p; }
#define ARG(f) (args_hidden()->f)
template <class Tp> __device__ __forceinline__ Tp* to_generic(Tp GAS* p) { return (Tp*)p; }
#define ARGP(f) to_generic(args_hidden()->f)
__device__ __forceinline__ float siluf_(float v) { return v / (1.f + fexp(-v)); }

__device__ __forceinline__ void ada_phase(LAS unsigned char* lds, const float* __restrict__ cin, const float* __restrict__ w_ada, const float* __restrict__ b_ada, float* __restrict__ MOD, int G, int c) {
    LAS float* cond = (LAS float*)lds; LAS float* part = (LAS float*)(lds + 32768);
    const int tid = tid_hidden();
    __syncthreads();
    for (int i = tid; i < NB * D; i += 512) cond[i] = siluf_(cin[i]);
    __syncthreads();
    for (int cb = c; cb < 256; cb += G) {
        const int col0 = cb * 96, l = col0 / (6 * D), j0 = col0 - l * 6 * D;
        if (tid < 384) {
            const int cl = tid % 96, kp = tid / 96;
            const float* w = w_ada + ((size_t)l * D + kp * 256) * 6 * D + j0 + cl;
            float acc[NB];
#pragma unroll
            for (int b = 0; b < NB; ++b) acc[b] = 0.f;
#pragma unroll 16
            for (int k = 0; k < 256; ++k) {
                const float wv = w[(size_t)k * 6 * D];
#pragma unroll
                for (int b = 0; b < NB; ++b) acc[b] += cond[b * D + kp * 256 + k] * wv;
            }
#pragma unroll
            for (int b = 0; b < NB; ++b) part[(kp * 96 + cl) * 8 + b] = acc[b];
        }
        __syncthreads();
        for (int o = tid; o < 96 * 8; o += 512) {
            const int cl = o >> 3, b = o & 7;
            const float s = part[(0 * 96 + cl) * 8 + b] + part[(1 * 96 + cl) * 8 + b] + part[(2 * 96 + cl) * 8 + b] + part[(3 * 96 + cl) * 8 + b] + b_ada[l * 6 * D + j0 + cl];
            MOD[((size_t)l * NB + b) * 6 * D + j0 + cl] = s;
        }
        __syncthreads();
    }
}
__device__ __forceinline__ void misc_phase(const float* __restrict__ lbl, const int* __restrict__ pos, float* __restrict__ lower, float* __restrict__ rope, int G, int c) {
    for (int gid = c * 512 + tid_hidden(); gid < T * 8; gid += G * 512) {
        if (gid < 1024) {
            float v0 = lbl[gid], v1 = lbl[1024 + gid], v2 = lbl[2048 + gid], v3 = lbl[3072 + gid];
            const float m = fmaxf(fmaxf(v0, v1), fmaxf(v2, v3));
            v0 = expf(v0 - m); v1 = expf(v1 - m); v2 = expf(v2 - m); v3 = expf(v3 - m);
            const float s = (v0 + v1) + (v2 + v3);
            lower[gid] = 0.f; lower[1024 + gid] = v1 / s; lower[2048 + gid] = v1 / s + v2 / s; lower[3072 + gid] = v1 / s + v2 / s + v3 / s;
        }
        const int t = gid >> 3, i = gid & 7;
        const double inv = pow(500000.0, -(double)i / 8.0);
        const double ang = (double)((float)pos[t]) * (double)((float)inv);
        rope[t * 16 + i] = (float)cos(ang);
        rope[t * 16 + 8 + i] = (float)sin(ang);
    }
}
__device__ __forceinline__ void conv_load(f32x4 (&v)[8], const float* __restrict__ sp, int N, int kt, int nt, int mode, int tid) {
    const int n4 = (tid & 15) * 4, kr = tid >> 4;
    int scol = nt * 64 + n4;
    if (mode == 1) { const int pn = scol >> 8, u = scol & 255, w = u & 127, rho = w & 31; scol = (u >> 7) * 1024 + pn * 128 + (w & ~31) + 8 * ((rho & 15) >> 2) + 4 * (rho >> 4); }
    if (mode == 2) { const int rho = scol & 31; scol = (scol & ~31) + 8 * ((rho & 15) >> 2) + 4 * (rho >> 4); }
#pragma unroll
    for (int i = 0; i < 8; ++i) v[i] = __builtin_nontemporal_load((const f32x4*)(sp + (size_t)(kt * 128 + kr + 16 * i) * N + scol));
}
__device__ __forceinline__ void conv_put(LAS float* tile, const f32x4 (&v)[8], int tid) {
    const int n4 = (tid & 15) * 4, kr = tid >> 4;
#pragma unroll
    for (int i = 0; i < 8; ++i)
#pragma unroll
        for (int j = 0; j < 4; ++j) tile[(kr + 16 * i) * 65 + n4 + j] = v[i][j];
}
__device__ __forceinline__ void conv_tile_out(LAS const float* tile, bf16_t* __restrict__ dp, int kt, int nt, int tid) {
    const int n = tid >> 2, kc = (tid & 3) * 32;
    bf16_t* o = dp + (size_t)(nt * 64 + n) * 1024 + kt * 128 + kc;
#pragma unroll
    for (int h = 0; h < 4; ++h) {
        unsigned w[4];
#pragma unroll
        for (int i = 0; i < 4; ++i) w[i] = cvt_pk_bf16(tile[(kc + h * 8 + 2 * i) * 65 + n], tile[(kc + h * 8 + 2 * i + 1) * 65 + n]);
        *(u32x4*)(o + h * 8) = (u32x4){w[0], w[1], w[2], w[3]};
    }
}
__device__ __forceinline__ void conv_tile_out8(LAS const float* tile, unsigned char* __restrict__ dp, int kt, int nt, int tid) {
    const int n = tid >> 2, kc = (tid & 3) * 32;
    unsigned char* o = dp + (size_t)(nt * 64 + n) * 1024 + kt * 128 + kc;
#pragma unroll
    for (int h = 0; h < 2; ++h) {
        unsigned w[4];
#pragma unroll
        for (int i = 0; i < 4; ++i) { const int k = kc + h * 16 + 4 * i; w[i] = cvt_pk4_fp8(tile[k * 65 + n] * W8_SCALE, tile[(k + 1) * 65 + n] * W8_SCALE, tile[(k + 2) * 65 + n] * W8_SCALE, tile[(k + 3) * 65 + n] * W8_SCALE); }
        *(u32x4*)(o + h * 16) = (u32x4){w[0], w[1], w[2], w[3]};
    }
}
struct ConvJob { const float* sp; unsigned char* dp; int N, kt, nt, mode, f8; };
__device__ __forceinline__ bool conv_job(int it, int half, const float* __restrict__ w_in, const float* __restrict__ w_out, const float* __restrict__ w_gu, const float* __restrict__ w_down, unsigned char* ws, ConvJob& jb) {
    constexpr int T_IN = 8 * 52, T_OUT = 8 * 16, T_GU = NE * 8 * 32, T_DN = NE * 8 * 16, T_L = T_IN + T_OUT + T_GU + T_DN;
    if (it * 2 >= DEPTH * T_L) return false;
    const int ti = it * 2 + half;
    const int l = ti / T_L; int r = ti - l * T_L;
    jb.mode = 0; jb.f8 = 0;
    if (r < T_IN) { jb.sp = w_in + (size_t)l * D * INW; jb.dp = ws + W_WINT + (size_t)l * INW * 2048; jb.N = INW; jb.mode = 2; }
    else if ((r -= T_IN) < T_OUT) { jb.sp = w_out + (size_t)l * D * D; jb.dp = ws + W_WOUTT + (size_t)l * D * 2048; jb.N = D; jb.mode = 2; }
    else if ((r -= T_OUT) < T_GU) { const int m = r / 256; r -= m * 256; jb.sp = w_gu + ((size_t)l * NE + m) * D * 2048; jb.dp = ws + W_WGUT + ((size_t)l * NE + m) * 2048 * 1024; jb.N = 2048; jb.mode = 1; jb.f8 = 1; }
    else { r -= T_GU; const int m = r / 128; r -= m * 128; jb.sp = w_down + ((size_t)l * NE + m) * DFF * D; jb.dp = ws + W_WDT + ((size_t)l * NE + m) * D * 1024; jb.N = D; jb.mode = 2; jb.f8 = 1; }
    const int tn = jb.N / 64; jb.kt = r / tn; jb.nt = r - jb.kt * tn;
    return true;
}
__device__ __forceinline__ void conv_finish(LAS float* tile, const f32x4 (&v)[8], const ConvJob& jb, int t256) {
    asm volatile("s_waitcnt lgkmcnt(0)" ::: "memory"); __builtin_amdgcn_s_barrier();
    conv_put(tile, v, t256);
    asm volatile("s_waitcnt lgkmcnt(0)" ::: "memory"); __builtin_amdgcn_s_barrier();
    if (jb.f8) conv_tile_out8(tile, jb.dp, jb.kt, jb.nt, t256); else conv_tile_out(tile, (bf16_t*)jb.dp, jb.kt, jb.nt, t256);
}
__device__ __forceinline__ void conv_phase(LAS unsigned char* lds, const float* __restrict__ w_in, const float* __restrict__ w_out, const float* __restrict__ w_gu, const float* __restrict__ w_down, unsigned char* ws, int G, int c) {
    const int tid = tid_hidden(), half = tid >> 8, t256 = tid & 255;
    LAS float* tile = (LAS float*)(lds + half * 33280);
    ConvJob j0, j1, j2; f32x4 v0[8], v1[8], v2[8];
    int it = c;
    bool h0 = conv_job(it, half, w_in, w_out, w_gu, w_down, ws, j0); if (h0) conv_load(v0, j0.sp, j0.N, j0.kt, j0.nt, j0.mode, t256); it += G;
    bool h1 = conv_job(it, half, w_in, w_out, w_gu, w_down, ws, j1); if (h1) conv_load(v1, j1.sp, j1.N, j1.kt, j1.nt, j1.mode, t256); it += G;
    for (;;) {
        const bool h2 = conv_job(it, half, w_in, w_out, w_gu, w_down, ws, j2); if (h2) conv_load(v2, j2.sp, j2.N, j2.kt, j2.nt, j2.mode, t256); it += G;
        if (!h0) break;
        conv_finish(tile, v0, j0, t256);
        h0 = conv_job(it, half, w_in, w_out, w_gu, w_down, ws, j0); if (h0) conv_load(v0, j0.sp, j0.N, j0.kt, j0.nt, j0.mode, t256); it += G;
        if (!h1) break;
        conv_finish(tile, v1, j1, t256);
        h1 = conv_job(it, half, w_in, w_out, w_gu, w_down, ws, j1); if (h1) conv_load(v1, j1.sp, j1.N, j1.kt, j1.nt, j1.mode, t256); it += G;
        if (!h2) break;
        conv_finish(tile, v2, j2, t256);
    }
    __syncthreads();
}
__device__ __forceinline__ void wrp_phase(const float* __restrict__ norm2, const float* __restrict__ w_router, const float* __restrict__ b_router, unsigned char* ws, int G, int c) {
    const float* MOD = (const float*)(ws + W_MOD); float* WRP = (float*)(ws + W_WRP); float* BRP = (float*)(ws + W_BRP);
    const int tid = tid_hidden();
    for (int i = c * 512 + tid; i < DEPTH * NB * D * NE; i += G * 512) {
        const int e = i & 31, k = (i >> 5) & 1023, b = (i >> 15) & 7, l = i >> 18;
        const float sc = MOD[((size_t)l * NB + b) * 6 * D + 4 * D + k];
        const float wv = norm2[l * D + k] * (1.f + sc) * w_router[((size_t)l * D + k) * NE + e];
        const bf16_t hi = f2bf(wv), lo = f2bf(wv - bf2f(hi));
        bf16_t* WH = (bf16_t*)WRP; bf16_t* WL = WH + (size_t)DEPTH * NB * D * NE;
        const size_t wi = ((size_t)(l * NB + b) * 128 + (k >> 3)) * 256 + e * 8 + (k & 7);
        WH[wi] = hi; WL[wi] = lo;
    }
    const int wid = tid >> 6, lane = tid & 63;
    for (int o = c * 8 + wid; o < DEPTH * NB * NE; o += G * 8) {
        const int e = o & 31, b = (o >> 5) & 7, l = o >> 8;
        float s = 0.f;
        for (int k = lane; k < D; k += 64) s += MOD[((size_t)l * NB + b) * 6 * D + 3 * D + k] * w_router[((size_t)l * D + k) * NE + e];
        for (int of = 32; of > 0; of >>= 1) s += shx(s, of);
        if (lane == 0) BRP[o] = s + b_router[l * NE + e];
    }
}
__device__ __forceinline__ void norm_phase(const float* __restrict__ X, const float* __restrict__ gain, const float* __restrict__ mod_l, int sh_off, int sc_off, bf16_t* __restrict__ H, bf16_t* __restrict__ Xb, int G, int c) {
    const int tidh = tid_hidden(), wid = tidh >> 6, lane = tidh & 63;
    for (int blk = c; blk < T / 64; blk += G) {
        const int t0 = blk * 64 + wid * 8, b = t0 / SEQ, k0 = lane * 16;
        const float* mb = mod_l + (size_t)b * 6 * D;
        f32x4 gn[4], sh[4];
#pragma unroll
        for (int q = 0; q < 4; ++q) { const f32x4 g = *(const f32x4*)(gain + k0 + 4 * q), sc = *(const f32x4*)(mb + sc_off + k0 + 4 * q); sh[q] = *(const f32x4*)(mb + sh_off + k0 + 4 * q); gn[q] = g * (sc + 1.f); }
#pragma unroll 4
        for (int i = 0; i < 8; ++i) {
            const size_t t = (size_t)t0 + i;
            f32x4 v[4]; float ss = 0.f;
#pragma unroll
            for (int q = 0; q < 4; ++q) { v[q] = *(const f32x4*)(X + t * D + k0 + 4 * q); ss += v[q][0] * v[q][0] + v[q][1] * v[q][1] + v[q][2] * v[q][2] + v[q][3] * v[q][3]; }
            for (int of = 32; of > 0; of >>= 1) ss += shx(ss, of);
            const float r = rsqrtf(ss * (1.f / D) + kf(EPS));
            u32x4 x0, x1, h0, h1;
            x0.x = cvt_pk_bf16(v[0][0], v[0][1]); x0.y = cvt_pk_bf16(v[0][2], v[0][3]); x0.z = cvt_pk_bf16(v[1][0], v[1][1]); x0.w = cvt_pk_bf16(v[1][2], v[1][3]);
            x1.x = cvt_pk_bf16(v[2][0], v[2][1]); x1.y = cvt_pk_bf16(v[2][2], v[2][3]); x1.z = cvt_pk_bf16(v[3][0], v[3][1]); x1.w = cvt_pk_bf16(v[3][2], v[3][3]);
            *(u32x4*)(Xb + t * D + k0) = x0; *(u32x4*)(Xb + t * D + k0 + 8) = x1;
            f32x4 o[4];
#pragma unroll
            for (int q = 0; q < 4; ++q) o[q] = v[q] * r * gn[q] + sh[q];
            h0.x = cvt_pk_bf16(o[0][0], o[0][1]); h0.y = cvt_pk_bf16(o[0][2], o[0][3]); h0.z = cvt_pk_bf16(o[1][0], o[1][1]); h0.w = cvt_pk_bf16(o[1][2], o[1][3]);
            h1.x = cvt_pk_bf16(o[2][0], o[2][1]); h1.y = cvt_pk_bf16(o[2][2], o[2][3]); h1.z = cvt_pk_bf16(o[3][0], o[3][1]); h1.w = cvt_pk_bf16(o[3][2], o[3][3]);
            *(u32x4*)(H + t * D + k0) = h0; *(u32x4*)(H + t * D + k0 + 8) = h1;
        }
    }
}

namespace rt {
typedef float f32x16 __attribute__((ext_vector_type(16)));
constexpr int XRB = 2064;
constexpr int XT_BYTES = 64 * XRB;
constexpr int O_RS = XT_BYTES, O_LG = O_RS + 256, O_SE = O_LG + 64 * 33 * 4, O_SG = O_SE + 1024, O_SR = O_SG + 1024, O_LC = O_SR + 1024, O_BASE = O_LC + 128, O_ENDR = O_BASE + 128;
static_assert(O_ENDR <= LDS_BAR_OFF, "router LDS map");
__device__ __forceinline__ void router_phase(LAS unsigned char* lds, const bf16_t* __restrict__ X, const float* __restrict__ gain, const float* __restrict__ mod_l,
                                             const bf16_t* __restrict__ WH_l, const bf16_t* __restrict__ WL_l, const float* __restrict__ BRP_l, bf16_t* __restrict__ H2B, int* __restrict__ cnt_l,
                                             int* __restrict__ LTOK, float* __restrict__ LGATE, int* __restrict__ PE, int* __restrict__ PR, int G, int c) {
    const int tid = tid_hidden(), wid = __builtin_amdgcn_readfirstlane(tid >> 6), lane = tid & 63;
    LAS float* rs = (LAS float*)(lds + O_RS); LAS float* lg = (LAS float*)(lds + O_LG);
    LAS int* se = (LAS int*)(lds + O_SE); LAS float* sg = (LAS float*)(lds + O_SG); LAS int* sr = (LAS int*)(lds + O_SR);
    LAS int* lc = (LAS int*)(lds + O_LC); LAS int* base = (LAS int*)(lds + O_BASE);
    for (int blk = c; blk < T / 64; blk += G) {
        const int tok0 = blk * 64, b = tok0 / SEQ;
        const float* mb = mod_l + (size_t)b * 6 * D;
        u32x4 xr[16];
#pragma unroll
        for (int i = 0; i < 16; ++i) { const int idx = tid + i * 512, r = idx >> 7, c8 = idx & 127; xr[i] = *(const u32x4*)(X + (size_t)(tok0 + r) * D + c8 * 8); }
        const int r31 = lane & 31, kg = lane >> 5;
        f32x4 mg[4], ms[4];
#pragma unroll
        for (int q = 0; q < 4; ++q) { const int k = lane * 16 + q * 4;
            const f32x4 g = *(const f32x4*)(gain + k), sc = *(const f32x4*)(mb + 4 * D + k), sh = *(const f32x4*)(mb + 3 * D + k);
            mg[q] = g * (sc + 1.f) * H28_SCALE; ms[q] = sh * H28_SCALE; }
        __syncthreads();
        if (tid < 32) lc[tid] = 0;
#pragma unroll
        for (int i = 0; i < 16; ++i) { const int idx = tid + i * 512, r = idx >> 7, c8 = idx & 127; *(LAS u32x4*)(lds + r * XRB + c8 * 16) = xr[i]; }
        bf16x8 bh[8], bl[8];
#pragma unroll
        for (int i = 0; i < 8; ++i) { const size_t o = ((size_t)b * 128 + wid * 16 + i * 2 + kg) * 256 + r31 * 8; bh[i] = *(const bf16x8*)(WH_l + o); bl[i] = *(const bf16x8*)(WL_l + o); }
        asm volatile("s_waitcnt lgkmcnt(0)" ::: "memory"); __builtin_amdgcn_s_barrier();
#pragma unroll 1
        for (int hb = 0; hb < 4; ++hb) {
            f32x4 v[2][4]; float ss[2];
#pragma unroll
            for (int rr = 0; rr < 2; ++rr) { const int r = wid * 8 + hb * 2 + rr;
                const u32x4 w0 = *(const LAS u32x4*)(lds + r * XRB + lane * 32), w1 = *(const LAS u32x4*)(lds + r * XRB + lane * 32 + 16);
                v[rr][0] = (f32x4){__uint_as_float(w0.x << 16), __uint_as_float(w0.x & 0xffff0000u), __uint_as_float(w0.y << 16), __uint_as_float(w0.y & 0xffff0000u)};
                v[rr][1] = (f32x4){__uint_as_float(w0.z << 16), __uint_as_float(w0.z & 0xffff0000u), __uint_as_float(w0.w << 16), __uint_as_float(w0.w & 0xffff0000u)};
                v[rr][2] = (f32x4){__uint_as_float(w1.x << 16), __uint_as_float(w1.x & 0xffff0000u), __uint_as_float(w1.y << 16), __uint_as_float(w1.y & 0xffff0000u)};
                v[rr][3] = (f32x4){__uint_as_float(w1.z << 16), __uint_as_float(w1.z & 0xffff0000u), __uint_as_float(w1.w << 16), __uint_as_float(w1.w & 0xffff0000u)};
                ss[rr] = 0.f;
#pragma unroll
                for (int q = 0; q < 4; ++q) ss[rr] += v[rr][q][0] * v[rr][q][0] + v[rr][q][1] * v[rr][q][1] + v[rr][q][2] * v[rr][q][2] + v[rr][q][3] * v[rr][q][3]; }
            for (int of = 32; of > 0; of >>= 1) {
#pragma unroll
                for (int rr = 0; rr < 2; ++rr) ss[rr] += shx(ss[rr], of);
            }
#pragma unroll
            for (int rr = 0; rr < 2; ++rr) {
                const int r = wid * 8 + hb * 2 + rr; const size_t t = (size_t)tok0 + r;
                const float rstd = rsqrtf(ss[rr] * (1.f / D) + kf(EPS));
                if (lane == 0) rs[r] = rstd;
                u32x4 hw;
                { const f32x4 o = v[rr][0] * rstd * mg[0] + ms[0]; hw.x = cvt_pk4_fp8(o[0], o[1], o[2], o[3]); }
                { const f32x4 o = v[rr][1] * rstd * mg[1] + ms[1]; hw.y = cvt_pk4_fp8(o[0], o[1], o[2], o[3]); }
                { const f32x4 o = v[rr][2] * rstd * mg[2] + ms[2]; hw.z = cvt_pk4_fp8(o[0], o[1], o[2], o[3]); }
                { const f32x4 o = v[rr][3] * rstd * mg[3] + ms[3]; hw.w = cvt_pk4_fp8(o[0], o[1], o[2], o[3]); }
                *(u32x4*)((unsigned char*)H2B + t * D + lane * 16) = hw;
            }
        }
        f32x16 acc0, acc1;
#pragma unroll
        for (int i = 0; i < 16; ++i) { acc0[i] = 0.f; acc1[i] = 0.f; }
#pragma unroll
        for (int i = 0; i < 8; ++i) {
            const bf16x8 a0 = *(const LAS bf16x8*)(lds + r31 * XRB + (wid * 128 + i * 16 + kg * 8) * 2);
            const bf16x8 a1 = *(const LAS bf16x8*)(lds + (32 + r31) * XRB + (wid * 128 + i * 16 + kg * 8) * 2);
            acc0 = __builtin_amdgcn_mfma_f32_32x32x16_bf16(a0, bh[i], acc0, 0, 0, 0);
            acc1 = __builtin_amdgcn_mfma_f32_32x32x16_bf16(a1, bh[i], acc1, 0, 0, 0);
            acc0 = __builtin_amdgcn_mfma_f32_32x32x16_bf16(a0, bl[i], acc0, 0, 0, 0);
            acc1 = __builtin_amdgcn_mfma_f32_32x32x16_bf16(a1, bl[i], acc1, 0, 0, 0);
        }
        __syncthreads();
        LAS float* part = (LAS float*)lds;
#pragma unroll
        for (int i = 0; i < 16; ++i) { part[(wid * 2 + 0) * 1024 + i * 64 + lane] = acc0[i]; part[(wid * 2 + 1) * 1024 + i * 64 + lane] = acc1[i]; }
        __syncthreads();
#pragma unroll
        for (int j = 0; j < 4; ++j) {
            const int o = tid + j * 512, rg = o >> 10, reg = (o >> 6) & 15, ln = o & 63;
            float sm = 0.f;
#pragma unroll
            for (int w = 0; w < 8; ++w) sm += part[(w * 2 + rg) * 1024 + reg * 64 + ln];
            const int e = ln & 31, row = rg * 32 + (reg & 3) + 8 * (reg >> 2) + 4 * (ln >> 5);
            lg[row * 33 + e] = sm * rs[row] + BRP_l[b * NE + e];
        }
        __syncthreads();
        if (tid < 64) {
            const int row = tid; unsigned used = 0u; int idx[4]; float val[4];
#pragma unroll
            for (int k = 0; k < 4; ++k) {
                float bv = kf(-3.0e38f); int bi = 0;
                for (int e = 0; e < 32; ++e) { const float v = lg[row * 33 + e]; if (!((used >> e) & 1u) && v > bv) { bv = v; bi = e; } }
                used |= 1u << bi; idx[k] = bi; val[k] = bv;
            }
            float ex[4], sm = 0.f;
#pragma unroll
            for (int k = 0; k < 4; ++k) { ex[k] = fexp(val[k] - val[0]); sm += ex[k]; }
#pragma unroll
            for (int k = 0; k < 4; ++k) {
                const int slot = row * 4 + k;
                se[slot] = idx[k]; sg[slot] = ex[k] / sm; sr[slot] = __hip_atomic_fetch_add(&lc[idx[k]], 1, __ATOMIC_RELAXED, __HIP_MEMORY_SCOPE_WORKGROUP);
            }
        }
        __syncthreads();
        if (tid < 32) base[tid] = atomicAdd(&cnt_l[tid], lc[tid]);
        __syncthreads();
        if (tid < 256) {
            const int e = se[tid], rank = base[e] + sr[tid], t = tok0 + (tid >> 2);
            LTOK[(size_t)e * T + rank] = t; LGATE[(size_t)e * T + rank] = sg[tid]; PE[t * 4 + (tid & 3)] = e; PR[t * 4 + (tid & 3)] = rank;
        }
    }
}
}

__device__ __forceinline__ void combine_phase(LAS unsigned char* lds, const bf16_t* X, bf16_t* Xo, const unsigned char* __restrict__ YB, const float* __restrict__ mod_l, const int* __restrict__ cnt_l,
                                              const int* __restrict__ PE, const int* __restrict__ PR, const float* __restrict__ gain, const float* __restrict__ mod_n,
                                              bf16_t* __restrict__ H1B, float* __restrict__ out, int G, int c) {
    const int tid = tid_hidden(), wid = tid >> 6, lane = tid & 63;
    LAS int* offp = (LAS int*)lds;
    __syncthreads();
    if (tid == 0) { int run = 0; for (int e = 0; e < NE; ++e) { offp[e] = run; run += ((cnt_l[e] + 255) >> 8) << 8; } }
    __syncthreads();
    for (int blk = c; blk < T / 64; blk += G) {
        const int t0 = blk * 64 + wid * 8, b = t0 / SEQ, k0 = lane * 16;
        f32x4 g2[4], gn[4], sh[4];
#pragma unroll
        for (int q = 0; q < 4; ++q) {
            g2[q] = *(const f32x4*)(mod_l + (size_t)b * 6 * D + 5 * D + k0 + 4 * q) * (1.f / Y8_SCALE);
            const f32x4 g = *(const f32x4*)(gain + k0 + 4 * q);
            if (mod_n) { const f32x4 sc = *(const f32x4*)(mod_n + (size_t)b * 6 * D + D + k0 + 4 * q); sh[q] = *(const f32x4*)(mod_n + (size_t)b * 6 * D + k0 + 4 * q); gn[q] = g * (sc + 1.f); }
            else { gn[q] = g; sh[q] = (f32x4){0.f, 0.f, 0.f, 0.f}; }
        }
        int rowv = 0;
        if (lane < 32) { const int e = PE[t0 * 4 + lane], rk = PR[t0 * 4 + lane]; rowv = offp[e] + rk; }
#pragma unroll 2
        for (int i = 0; i < 8; ++i) {
            const int t = t0 + i;
            u32x4 yv[4];
#pragma unroll
            for (int k = 0; k < 4; ++k) { const int row = __builtin_amdgcn_readlane(rowv, i * 4 + k); yv[k] = *(const u32x4*)(YB + (size_t)row * D + k0); }
            const u32x4 x0 = *(const u32x4*)(X + (size_t)t * D + k0), x1 = *(const u32x4*)(X + (size_t)t * D + k0 + 8);
            f32x4 v[4]; float ss = 0.f;
#pragma unroll
            for (int q = 0; q < 4; ++q) {
                f32x4 a = (f32x4){0.f, 0.f, 0.f, 0.f};
#pragma unroll
                for (int k = 0; k < 4; ++k) { const unsigned w = q == 0 ? yv[k].x : q == 1 ? yv[k].y : q == 2 ? yv[k].z : yv[k].w;
                    const f32x2_t lo = __builtin_amdgcn_cvt_pk_f32_fp8((int)w, false), hi = __builtin_amdgcn_cvt_pk_f32_fp8((int)w, true);
                    a[0] += lo.x; a[1] += lo.y; a[2] += hi.x; a[3] += hi.y; }
                const u32x4 xq = (q >> 1) ? x1 : x0; const unsigned xa = (q & 1) ? xq.z : xq.x, xb = (q & 1) ? xq.w : xq.y;
                v[q] = (f32x4){__uint_as_float(xa << 16), __uint_as_float(xa & 0xffff0000u), __uint_as_float(xb << 16), __uint_as_float(xb & 0xffff0000u)} + g2[q] * a;
                ss += v[q][0] * v[q][0] + v[q][1] * v[q][1] + v[q][2] * v[q][2] + v[q][3] * v[q][3];
            }
            for (int of = 32; of > 0; of >>= 1) ss += shx(ss, of);
            const float r = rsqrtf(ss * (1.f / D) + kf(EPS));
            if (mod_n) {
                u32x4 xo0, xo1, h0, h1;
                xo0.x = cvt_pk_bf16(v[0][0], v[0][1]); xo0.y = cvt_pk_bf16(v[0][2], v[0][3]); xo0.z = cvt_pk_bf16(v[1][0], v[1][1]); xo0.w = cvt_pk_bf16(v[1][2], v[1][3]);
                xo1.x = cvt_pk_bf16(v[2][0], v[2][1]); xo1.y = cvt_pk_bf16(v[2][2], v[2][3]); xo1.z = cvt_pk_bf16(v[3][0], v[3][1]); xo1.w = cvt_pk_bf16(v[3][2], v[3][3]);
                *(u32x4*)(Xo + (size_t)t * D + k0) = xo0; *(u32x4*)(Xo + (size_t)t * D + k0 + 8) = xo1;
                f32x4 o[4];
#pragma unroll
                for (int q = 0; q < 4; ++q) o[q] = v[q] * r * gn[q] + sh[q];
                h0.x = cvt_pk_bf16(o[0][0], o[0][1]); h0.y = cvt_pk_bf16(o[0][2], o[0][3]); h0.z = cvt_pk_bf16(o[1][0], o[1][1]); h0.w = cvt_pk_bf16(o[1][2], o[1][3]);
                h1.x = cvt_pk_bf16(o[2][0], o[2][1]); h1.y = cvt_pk_bf16(o[2][2], o[2][3]); h1.z = cvt_pk_bf16(o[3][0], o[3][1]); h1.w = cvt_pk_bf16(o[3][2], o[3][3]);
                *(u32x4*)(H1B + (size_t)t * D + k0) = h0; *(u32x4*)(H1B + (size_t)t * D + k0 + 8) = h1;
            } else {
#pragma unroll
                for (int q = 0; q < 4; ++q) *(f32x4*)(out + (size_t)t * D + k0 + 4 * q) = v[q] * r * gn[q];
            }
        }
    }
}

#ifndef PROBE
#endif
constexpr int N_PHASES = 2 + 9 * DEPTH;
__global__ void __launch_bounds__(512, 2) fwd(Args a) {
    extern __shared__ __attribute__((aligned(16))) unsigned char lds_raw[];
    LAS unsigned char* lds0 = (LAS unsigned char*)lds_raw;
#define GGX sgpr_hidden((int)gridDim.x)
#define CCX sgpr_hidden((int)blockIdx.x)
#define lds lds_hidden(lds0)
    if (threadIdx.x == 0) { ((LAS unsigned*)(lds0 + LDS_BAR_OFF))[0] = 0u; ((LAS unsigned*)(lds0 + LDS_BAR_OFF))[1] = 0u; }
    __syncthreads();
    (void)xcd_barrier_post((unsigned*)(unsigned GAS*)(args_hidden()->ws), (volatile LAS unsigned*)(lds0 + LDS_BAR_OFF));
    const int lo = ARG(ph_lo), hi = ARG(ph_hi);
#define IN(k) (lo <= (k) && (k) < hi)
#define FORCE_BAR() do { XcdBarrier bar_; bar_.bar = (unsigned*)(unsigned GAS*)ptr_hidden(args_hidden()->ws); bar_.x = xb_xcc_id(); bar_.st = (volatile LAS unsigned*)(lds + LDS_BAR_OFF); xcd_barrier(bar_); } while (0)
#if PROBE == 4
#define SEAM(k) do { if (IN(k) && IN((k) + 1)) { FORCE_BAR(); FORCE_BAR(); FORCE_BAR(); } } while (0)
#else
#define SEAM(k) do { if (IN(k) && IN((k) + 1)) { XcdBarrier bar_; bar_.bar = (unsigned*)(unsigned GAS*)ptr_hidden(args_hidden()->ws); bar_.x = xb_xcc_id(); bar_.st = (volatile LAS unsigned*)(lds + LDS_BAR_OFF); xcd_barrier(bar_); } } while (0)
#endif
#define WSP(type, off) ((type*)(type GAS*)ptr_hidden(args_hidden()->ws + (off)))
#define X WSP(bf16_t, W_X)
#define H1B WSP(bf16_t, W_H1B)
#define MIXB WSP(bf16_t, W_MIXB)
#define H2B WSP(bf16_t, W_H2B)
#define QA WSP(bf16_t, W_QA)
#define KA WSP(bf16_t, W_KA)
#define VTA WSP(bf16_t, W_VTA)
#define QH WSP(bf16_t, W_QH)
#define LF WSP(bf16_t, W_LF)
#define VTH WSP(bf16_t, W_VTH)
#define GS WSP(bf16_t, W_GS)
#define AO WSP(bf16_t, W_AO)
#define SSQ WSP(float, W_SSQ)
#define UT WSP(bf16_t, W_UT)
#define SIN WSP(bf16_t, W_SIN)
#define DEC WSP(float, W_DEC)
#define MOD WSP(float, W_MOD)
#define LOW WSP(float, W_LOW)
#define ROPE WSP(float, W_ROPE)
#define WRP WSP(float, W_WRP)
#define BRP WSP(float, W_BRP)
#define LTOK WSP(int, W_LTOK)
#define LGATE WSP(float, W_LGATE)
#define PE WSP(int, W_PE)
#define PR WSP(int, W_PR)
#define ACTB WSP(bf16_t, W_ACTB)
#define YB WSP(unsigned char, W_YB)
#define WINT WSP(bf16_t, W_WINT)
#define WOUTT WSP(bf16_t, W_WOUTT)
#define WGUT WSP(bf16_t, W_WGUT)
#define WDT WSP(bf16_t, W_WDT)
#define CNT WSP(int, W_CNT)
    if (IN(0)) { ada_phase(lds, ARGP(c), ARGP(w_ada), ARGP(b_ada), MOD, GGX, CCX); misc_phase(ARGP(lbl), ARGP(pos), LOW, ROPE, GGX, CCX); conv_phase(lds, ARGP(w_in), ARGP(w_out), ARGP(w_gu), ARGP(w_down), (unsigned char*)ptr_hidden(args_hidden()->ws), GGX, CCX); }
    SEAM(0);
    if (IN(1)) { wrp_phase(ARGP(norm2), ARGP(w_router), ARGP(b_router), (unsigned char*)ptr_hidden(args_hidden()->ws), GGX, CCX); norm_phase(ARGP(x), ARGP(norm1), MOD, 0, D, H1B, X, GGX, CCX); }
    SEAM(1);
#if PROBE == 1
    if (IN(0)) { ada_phase(lds, ARGP(c), ARGP(w_ada), ARGP(b_ada), MOD, GGX, CCX); misc_phase(ARGP(lbl), ARGP(pos), LOW, ROPE, GGX, CCX); conv_phase(lds, ARGP(w_in), ARGP(w_out), ARGP(w_gu), ARGP(w_down), (unsigned char*)ptr_hidden(args_hidden()->ws), GGX, CCX); }
    FORCE_BAR();
    if (IN(1)) { wrp_phase(ARGP(norm2), ARGP(w_router), ARGP(b_router), (unsigned char*)ptr_hidden(args_hidden()->ws), GGX, CCX); norm_phase(ARGP(x), ARGP(norm1), MOD, 0, D, H1B, X, GGX, CCX); }
    FORCE_BAR();
#endif
#pragma unroll 1
    for (int l = 0; l < DEPTH; ++l) {
        const int p0 = 2 + 9 * l;
#define mod_l (MOD + (size_t)l * NB * 6 * D)
#define cnt_l (CNT + l * NE)
        if (IN(p0 + 0)) {
            g8::DenseSrc S; S.init(H1B, WINT + (size_t)l * INW * 1024, 0, GGX == 256 ? 12 : 13, GGX, CCX);
            g8::EpiProj E{QA, KA, VTA, QH, LF, VTH, GS, ROPE, LOW + (size_t)l * 1024};
            g8::gemm_phase(lds, S, E);
        }
#if PROBE == 5
        if (IN(p0 + 0)) { FORCE_BAR();
            g8::DenseSrc S; S.init(H1B, WINT + (size_t)l * INW * 1024, 0, GGX == 256 ? 12 : 13, GGX, CCX);
            g8::EpiProj E{QA, KA, VTA, QH, LF, VTH, GS, ROPE, LOW + (size_t)l * 1024};
            g8::gemm_phase(lds, S, E);
        }
#endif
        SEAM(p0 + 0);
        if (IN(p0 + 1)) {
            const int g_ = GGX, c_ = CCX;
            if (g_ == 256) {
                { g8::DenseSrc S; S.init(H1B, WINT + (size_t)l * INW * 1024, 12, 1, g_, c_);
                  g8::EpiProj E{QA, KA, VTA, QH, LF, VTH, GS, ROPE, LOW + (size_t)l * 1024};
                  g8::gemm_phase(lds, S, E); }
                const int af = c_ < 64 ? 0 : (c_ < 128 ? (c_ - 64) * 2 : 128 + (c_ - 128)), an = c_ < 64 ? 0 : (c_ < 128 ? 2 : 1);
                const int cf = c_ < 64 ? c_ * 5 : (c_ < 128 ? 320 + (c_ - 64) : 384 + (c_ - 128) * 5), cn = c_ < 64 ? 5 : (c_ < 128 ? 1 : 5);
                att::attn_phase(lds, QA, KA, VTA, ARGP(sink) + l * 8, AO, SSQ, af, an, 1);
#if PROBE == 8
                att::attn_phase(lds, QA, KA, VTA, ARGP(sink) + l * 8, AO, SSQ, af, an, 1);
#endif
                hg::c1_phase(lds, LF, VTH, UT, DEC, cf, cn, 1);
#if PROBE == 9
                hg::c1_phase(lds, LF, VTH, UT, DEC, cf, cn, 1);
#endif
            } else {
                att::attn_phase(lds, QA, KA, VTA, ARGP(sink) + l * 8, AO, SSQ, c_, (NB * 32 - c_ + g_ - 1) / g_, g_);
                hg::c1_phase(lds, LF, VTH, UT, DEC, c_, (NB * 128 - c_ + g_ - 1) / g_, g_);
            }
        }
        SEAM(p0 + 1);
        if (IN(p0 + 2)) hg::c2_phase(UT, DEC, SIN, GGX, CCX);
#if PROBE == 10
        if (IN(p0 + 2)) hg::c2_phase(UT, DEC, SIN, GGX, CCX);
#endif
        SEAM(p0 + 2);
        if (IN(p0 + 3)) hg::c3_phase(lds, QH, LF, VTH, SIN, GS, ARGP(hg_norm) + l * 128, AO, SSQ, ARGP(attn_norm) + l * 512, MIXB, GGX, CCX);
#if PROBE == 11
        if (IN(p0 + 3)) hg::c3_phase(lds, QH, LF, VTH, SIN, GS, ARGP(hg_norm) + l * 128, AO, SSQ, ARGP(attn_norm) + l * 512, MIXB, GGX, CCX);
#endif
        SEAM(p0 + 3);
        if (IN(p0 + 4)) {
            g8::DenseSrc S; S.init(MIXB, WOUTT + (size_t)l * D * 1024, 0, D / 256, GGX, CCX);
            g8::EpiOutRes E{X, mod_l + 2 * D};
            g8::gemm_phase(lds, S, E);
        }
        SEAM(p0 + 4);
#if PROBE == 6
        if (IN(p0 + 5)) { rt::router_phase(lds, X, ARGP(norm2) + l * D, mod_l, WRP + (size_t)l * NB * D * NE, BRP + (size_t)l * NB * NE, MIXB, CNT + 128 + l * NE, (int*)ACTB, (float*)YB, (int*)UT, (int*)SIN, GGX, CCX); FORCE_BAR(); }
#endif
        if (IN(p0 + 5)) rt::router_phase(lds, X, ARGP(norm2) + l * D, mod_l, (const bf16_t*)WRP + (size_t)l * NB * D * NE, (const bf16_t*)WRP + (size_t)(DEPTH + l) * NB * D * NE, BRP + (size_t)l * NB * NE, H2B, cnt_l, LTOK, LGATE, PE, PR, GGX, CCX);
        SEAM(p0 + 5);
        if (IN(p0 + 6)) {
            g8::MoeSrc<true, 8, true> S; S.init(lds, H2B, LTOK, (const bf16_t*)((const unsigned char*)WGUT + (size_t)l * NE * 2048 * 1024), cnt_l, GGX, CCX); S.done = WSP(unsigned, W_DONE) + l * 512;
            g8::EpiGU E{(unsigned char*)ACTB, ARGP(b_gu) + (size_t)l * NE * 2048};
            g8::gemm_phase(lds, S, E);
        }
        if (IN(p0 + 6)) {
            g8::MoeSrc<false, 4, true, true, true> S; S.init(lds, ACTB, nullptr, (const bf16_t*)((const unsigned char*)WDT + (size_t)l * NE * 1024 * 1024), cnt_l, GGX, CCX); S.done = WSP(unsigned, W_DONE) + l * 512;
            g8::EpiDown E{YB, ARGP(b_down) + (size_t)l * NE * D, LGATE};
            g8::gemm_phase(lds, S, E);
        }
        SEAM(p0 + 7);
#if PROBE == 3
        if (IN(p0 + 6)) {
            g8::MoeSrc<true, 8, true> S; S.init(lds, H2B, LTOK, (const bf16_t*)((const unsigned char*)WGUT + (size_t)l * NE * 2048 * 1024), cnt_l, GGX, CCX);
            g8::EpiGU E{(unsigned char*)ACTB, ARGP(b_gu) + (size_t)l * NE * 2048};
            g8::gemm_phase(lds, S, E);
        }
        FORCE_BAR();
        if (IN(p0 + 7)) {
            g8::MoeSrc<false, 4, true> S; S.init(lds, ACTB, nullptr, (const bf16_t*)((const unsigned char*)WDT + (size_t)l * NE * 1024 * 1024), cnt_l, GGX, CCX);
            g8::EpiDown E{YB, ARGP(b_down) + (size_t)l * NE * D, LGATE};
            g8::gemm_phase(lds, S, E);
        }
        FORCE_BAR();
#endif
#if PROBE == 7
        if (IN(p0 + 8)) { combine_phase(lds, X, (float*)SIN, YB, mod_l, cnt_l, PE, PR, ARGP(norm1) + l * D, mod_l, MIXB, (float*)SIN, GGX, CCX); FORCE_BAR(); }
#endif
        if (IN(p0 + 8)) {
            const bool lastl = (l == DEPTH - 1);
            combine_phase(lds, X, X, YB, mod_l, cnt_l, PE, PR, lastl ? ARGP(final_norm) : ARGP(norm1) + (l + 1) * D, lastl ? nullptr : mod_l + NB * 6 * D, H1B, ARGP(out), GGX, CCX);
        }
        if (l + 1 < DEPTH) SEAM(p0 + 8);
    }
#undef GGX
#undef CCX
#undef lds
#undef IN
#undef SEAM
#undef FORCE_BAR
}
}

#ifndef N_LAUNCH_SPLIT
#define N_LAUNCH_SPLIT 0
#endif
extern "C" void kernel_launch(void* const* d_in, const int* in_sizes, int n_in, void* d_out, int out_size, void* d_ws, size_t ws_size, hipStream_t stream) {
    static int grid = 0;
    if (grid == 0) {
        int dev = 0, cus = 0;
        if (hipGetDevice(&dev) != hipSuccess || hipDeviceGetAttribute(&cus, hipDeviceAttributeMultiprocessorCount, dev) != hipSuccess || cus <= 0) cus = 256;
        (void)hipFuncSetAttribute((const void*)fwd, hipFuncAttributeMaxDynamicSharedMemorySize, g8::LDS_TOTAL);
        int per_cu = 0;
        (void)hipOccupancyMaxActiveBlocksPerMultiprocessor(&per_cu, (const void*)fwd, 512, g8::LDS_TOTAL);
        (void)hipGetLastError();
        grid = cus;
    }
    (void)hipMemsetAsync(d_ws, 0, CTL_BYTES, stream);
    Args a{};
    a.x = (const float*)d_in[0]; a.c = (const float*)d_in[1]; a.pos = (const int*)d_in[2]; a.w_ada = (const float*)d_in[3]; a.b_ada = (const float*)d_in[4];
    a.norm1 = (const float*)d_in[5]; a.w_in = (const float*)d_in[6]; a.sink = (const float*)d_in[7]; a.attn_norm = (const float*)d_in[8]; a.lbl = (const float*)d_in[9];
    a.hg_norm = (const float*)d_in[10]; a.w_out = (const float*)d_in[11]; a.norm2 = (const float*)d_in[12]; a.w_router = (const float*)d_in[13]; a.b_router = (const float*)d_in[14];
    a.w_gu = (const float*)d_in[15]; a.b_gu = (const float*)d_in[16]; a.w_down = (const float*)d_in[17]; a.b_down = (const float*)d_in[18]; a.final_norm = (const float*)d_in[19];
    a.out = (float*)d_out; a.ws = (unsigned char*)d_ws;
#if N_LAUNCH_SPLIT
    for (int p = 0; p < N_PHASES; ++p) { a.ph_lo = p; a.ph_hi = p + 1; hipLaunchKernelGGL(fwd, dim3(grid), dim3(512), g8::LDS_TOTAL, stream, a); }
#else
    a.ph_lo = 0; a.ph_hi = N_PHASES;
    hipLaunchKernelGGL(fwd, dim3(grid), dim3(512), g8::LDS_TOTAL, stream, a);
#endif
}
```
